# Optimizing an MI355X kernel written in HIP

```python
import math
import jax, jax.numpy as jnp
from jax import lax
import numpy as np

D_MODEL = 1024
BATCH = 8
SEQ = 2048
DEPTH = 2
DEC_BATCH = 128
DEC_SEQ = 8
PAST_LEN = 16384
PAGE_SIZE = 128

N_MIXERS = 2
N_SSM_LAYERS = (DEPTH + 1) // 2
N_POOL_LAYERS = DEPTH // 2
EXPAND = 2
D_INNER = EXPAND * D_MODEL
SSM_HEADDIM = 64
SSM_HEADS = D_INNER // SSM_HEADDIM
SSM_GROUPS = 8
SSM_HEADS_PER_GROUP = SSM_HEADS // SSM_GROUPS
D_STATE = 128
D_CONV = 4
CONV_DIM = D_INNER + 2 * SSM_GROUPS * D_STATE
IN_PROJ_DIM = D_INNER + CONV_DIM + SSM_HEADS
SSD_CHUNK = 128
POOL_WINDOWS = (2, 4, 8, 16)
POOL_GROUPS = len(POOL_WINDOWS)
POOL_GROUP_DIM = D_MODEL // POOL_GROUPS
POOL_BUF = max(POOL_WINDOWS) - 1
N_MEM = 256
XATTN_HEADS = 4
XATTN_HEAD_DIM = D_MODEL // XATTN_HEADS
D_FF = 4 * D_MODEL
EPS = 1e-5

kernel_name = 'hybrid_ssd_pool_memory_decoder_step'


def rmsnorm(x, g):
    xf = x.astype(jnp.float32)
    y = xf * lax.rsqrt(jnp.mean(xf * xf, axis=-1, keepdims=True) + EPS)
    return (y * g.astype(jnp.float32)).astype(x.dtype)


def ssd_scan(xs, dt, a, bm, cm, h0):
    f32 = jnp.float32
    b, L = xs.shape[0], xs.shape[1]
    q = min(SSD_CHUNK, L)
    nc = -(-L // q)
    pad = nc * q - L
    xs, dt, bm, cm = xs.astype(f32), dt.astype(f32), bm.astype(f32), cm.astype(f32)
    if pad:
        pw = lambda t: jnp.pad(t, [(0, 0), (0, pad)] + [(0, 0)] * (t.ndim - 2))
        xs, dt, bm, cm = pw(xs), pw(dt), pw(bm), pw(cm)
    G, R = SSM_GROUPS, SSM_HEADS_PER_GROUP
    x = xs.reshape(b, nc, q, G, R, SSM_HEADDIM)
    d = dt.reshape(b, nc, q, G, R)
    B = bm.reshape(b, nc, q, G, D_STATE)
    C = cm.reshape(b, nc, q, G, D_STATE)
    acs = jnp.cumsum(d * a.astype(f32).reshape(G, R), axis=2)
    causal = jnp.tril(jnp.ones((q, q), dtype=bool))
    seg = acs[:, :, :, None] - acs[:, :, None, :]
    decay = jnp.exp(jnp.where(causal[:, :, None, None], seg, -jnp.inf))
    xdt = x * d[..., None]
    cb = jnp.einsum('bclgn,bcsgn->bclsg', C, B)
    y_diag = jnp.einsum('bclsgr,bcsgrp->bclgrp', cb[..., None] * decay, xdt)
    decay_end = jnp.exp(acs[:, :, -1:] - acs)
    chunk_states = jnp.einsum('bcsgn,bcsgr,bcsgrp->bcgrpn', B, decay_end, xdt)
    chunk_decay = jnp.exp(acs[:, :, -1])

    def step(h, inp):
        st, dec = inp
        return h * dec[..., None, None] + st, h

    h_init = h0.astype(f32).reshape(b, G, R, SSM_HEADDIM, D_STATE)
    h_final, h_prev = lax.scan(step, h_init,
                               (jnp.moveaxis(chunk_states, 1, 0), jnp.moveaxis(chunk_decay, 1, 0)))
    h_prev = jnp.moveaxis(h_prev, 0, 1)
    y_off = jnp.einsum('bclgn,bcgrpn,bclgr->bclgrp', C, h_prev, jnp.exp(acs))
    y = (y_diag + y_off).reshape(b, nc * q, SSM_HEADS, SSM_HEADDIM)[:, :L]
    return y, h_final.reshape(b, SSM_HEADS, SSM_HEADDIM, D_STATE)


def mamba_mixer(u, conv_buf, ssm_state, w_in, conv_w, conv_b, dt_bias, a_log, d_skip, norm_gated, w_out):
    b, L, _ = u.shape
    zxbcdt = u @ w_in
    z = zxbcdt[..., :D_INNER]
    xbc = zxbcdt[..., D_INNER:D_INNER + CONV_DIM]
    dt_raw = zxbcdt[..., D_INNER + CONV_DIM:]
    xpad = jnp.concatenate([conv_buf.astype(xbc.dtype), xbc], axis=1)
    conv = conv_b + sum(xpad[:, k:k + L] * conv_w[k] for k in range(D_CONV))
    xbc_act = jax.nn.silu(conv)
    new_conv = xpad[:, L:]
    xs = xbc_act[..., :D_INNER].reshape(b, L, SSM_HEADS, SSM_HEADDIM)
    bm = xbc_act[..., D_INNER:D_INNER + SSM_GROUPS * D_STATE].reshape(b, L, SSM_GROUPS, D_STATE)
    cm = xbc_act[..., D_INNER + SSM_GROUPS * D_STATE:].reshape(b, L, SSM_GROUPS, D_STATE)
    dt = jax.nn.softplus(dt_raw.astype(jnp.float32) + dt_bias.astype(jnp.float32))
    a = -jnp.exp(a_log.astype(jnp.float32))
    y, new_state = ssd_scan(xs, dt, a, bm, cm, ssm_state)
    y = y + d_skip.astype(jnp.float32)[:, None] * xs.astype(jnp.float32)
    yg = y.reshape(b, L, D_INNER) * jax.nn.silu(z.astype(jnp.float32))
    yg = yg.reshape(b, L, SSM_GROUPS, D_INNER // SSM_GROUPS)
    yg = yg * lax.rsqrt(jnp.mean(yg * yg, axis=-1, keepdims=True) + EPS)
    yg = yg.reshape(b, L, D_INNER) * norm_gated.astype(jnp.float32)
    out = yg.astype(u.dtype) @ w_out
    return out, new_conv, new_state.astype(ssm_state.dtype)


def pool_mixer(u, buf, pos0, w_pool, pool_scale):
    b, L, D = u.shape
    uf = u.astype(jnp.float32)
    ext = jnp.concatenate([buf.astype(jnp.float32), uf], axis=1)
    cs = jnp.concatenate([jnp.zeros((b, 1, D), jnp.float32), jnp.cumsum(ext, axis=1)], axis=1)
    pos = pos0 + jnp.arange(L)
    W = POOL_BUF + 1
    outs = []
    for g, w in enumerate(POOL_WINDOWS):
        sl = slice(g * POOL_GROUP_DIM, (g + 1) * POOL_GROUP_DIM)
        win_sum = cs[:, W:W + L, sl] - cs[:, W - w:W - w + L, sl]
        cnt = jnp.minimum(pos + 1, w).astype(jnp.float32)[None, :, None]
        outs.append(win_sum / cnt)
    pooled = jnp.concatenate(outs, axis=-1) - uf
    mixed = jnp.einsum('blgc,gcd->blgd', pooled.reshape(b, L, POOL_GROUPS, POOL_GROUP_DIM),
                       w_pool.astype(jnp.float32)).reshape(b, L, D)
    out = (mixed * pool_scale.astype(jnp.float32)).astype(u.dtype)
    return out, ext[:, L:].astype(u.dtype)


def mem_kv(mem, g_mem, w_k, w_v):
    b, m, _ = mem.shape
    mn = rmsnorm(mem, g_mem)
    k = (mn @ w_k).reshape(b, m, XATTN_HEADS, XATTN_HEAD_DIM)
    v = (mn @ w_v).reshape(b, m, XATTN_HEADS, XATTN_HEAD_DIM)
    return k, v


def cross_attn(h, k, v, w_q, w_o):
    b, L, _ = h.shape
    q = (h @ w_q).reshape(b, L, XATTN_HEADS, XATTN_HEAD_DIM)
    s = jnp.einsum('blhd,bmhd->bhlm', q.astype(jnp.float32), k.astype(jnp.float32)) * (XATTN_HEAD_DIM ** -0.5)
    p = jax.nn.softmax(s, axis=-1)
    o = jnp.einsum('bhlm,bmhd->blhd', p, v.astype(jnp.float32)).reshape(b, L, D_MODEL)
    return o.astype(h.dtype) @ w_o


def sq_relu_mlp(h, w_up, w_down):
    a = jax.nn.relu(h @ w_up)
    return (a * a) @ w_down


def setup_inputs(seed: int = 0) -> dict:
    key = jax.random.key(seed)
    ks = jax.random.split(key, 32)
    f32 = jnp.float32
    nrm = lambda k, shape, s: jax.random.normal(k, shape, f32) * s
    gain = lambda k, shape: 1.0 + 0.1 * jax.random.normal(k, shape, f32)
    kv_shape = (DEPTH, DEC_BATCH, N_MEM, XATTN_HEADS, XATTN_HEAD_DIM)
    dt0 = jnp.exp(jax.random.uniform(ks[16], (N_SSM_LAYERS, SSM_HEADS), f32, math.log(1e-3), math.log(1e-1)))
    return {
        'x_prompt': nrm(ks[0], (BATCH, SEQ, D_MODEL), 1.0),
        'x_sample': nrm(ks[1], (DEC_BATCH, DEC_SEQ, D_MODEL), 1.0),
        'cache_mem_k': nrm(ks[2], kv_shape, 1.0),
        'cache_mem_v': nrm(ks[3], kv_shape, 1.0),
        'state_ssm': nrm(ks[4], (N_SSM_LAYERS, DEC_BATCH, SSM_HEADS, SSM_HEADDIM, D_STATE), 0.1),
        'state_conv': nrm(ks[5], (N_SSM_LAYERS, DEC_BATCH, D_CONV - 1, CONV_DIM), 1.0),
        'state_pool': nrm(ks[6], (N_POOL_LAYERS, DEC_BATCH, POOL_BUF, D_MODEL), 1.0),
        'mem_prompt': nrm(ks[7], (BATCH, N_MEM, D_MODEL), 1.0),
        'norm_mix': gain(ks[8], (DEPTH, D_MODEL)),
        'norm_xattn': gain(ks[9], (DEPTH, D_MODEL)),
        'norm_mem': gain(ks[10], (DEPTH, D_MODEL)),
        'norm_mlp': gain(ks[11], (DEPTH, D_MODEL)),
        'norm_final': gain(ks[12], (D_MODEL,)),
        'w_in': nrm(ks[13], (N_SSM_LAYERS, D_MODEL, IN_PROJ_DIM), D_MODEL ** -0.5),
        'conv_w': nrm(ks[14], (N_SSM_LAYERS, D_CONV, CONV_DIM), D_CONV ** -0.5),
        'conv_b': nrm(ks[15], (N_SSM_LAYERS, CONV_DIM), 0.01),
        'dt_bias': dt0 + jnp.log(-jnp.expm1(-dt0)),
        'a_log': jnp.log(jax.random.uniform(ks[17], (N_SSM_LAYERS, SSM_HEADS), f32, 1.0, 16.0)),
        'd_skip': gain(ks[18], (N_SSM_LAYERS, SSM_HEADS)),
        'norm_gated': gain(ks[19], (N_SSM_LAYERS, D_INNER)),
        'w_out': nrm(ks[20], (N_SSM_LAYERS, D_INNER, D_MODEL), D_INNER ** -0.5),
        'w_pool': nrm(ks[21], (N_POOL_LAYERS, POOL_GROUPS, POOL_GROUP_DIM, POOL_GROUP_DIM), POOL_GROUP_DIM ** -0.5),
        'pool_scale': gain(ks[22], (N_POOL_LAYERS, D_MODEL)),
        'w_xq': nrm(ks[23], (DEPTH, D_MODEL, D_MODEL), D_MODEL ** -0.5),
        'w_xk': nrm(ks[24], (DEPTH, D_MODEL, D_MODEL), D_MODEL ** -0.5),
        'w_xv': nrm(ks[25], (DEPTH, D_MODEL, D_MODEL), D_MODEL ** -0.5),
        'w_xo': nrm(ks[26], (DEPTH, D_MODEL, D_MODEL), D_MODEL ** -0.5),
        'w_up': nrm(ks[27], (DEPTH, D_MODEL, D_FF), D_MODEL ** -0.5),
        'w_down': nrm(ks[28], (DEPTH, D_FF, D_MODEL), D_FF ** -0.5),
    }


def reference(x_prompt, x_sample, cache_mem_k, cache_mem_v, state_ssm, state_conv, state_pool, mem_prompt,
              norm_mix, norm_xattn, norm_mem, norm_mlp, norm_final,
              w_in, conv_w, conv_b, dt_bias, a_log, d_skip, norm_gated, w_out,
              w_pool, pool_scale, w_xq, w_xk, w_xv, w_xo, w_up, w_down):
    xp, xs = x_prompt, x_sample
    bp = x_prompt.shape[0]
    mk_p, mv_p = [], []
    ssm_p, conv_p, pool_p = [], [], []
    ssm_s, conv_s, pool_s = [], [], []
    for i in range(DEPTH):
        j = i // N_MIXERS
        hp = rmsnorm(xp, norm_mix[i])
        hs = rmsnorm(xs, norm_mix[i])
        if i % N_MIXERS == 0:
            prm = (w_in[j], conv_w[j], conv_b[j], dt_bias[j], a_log[j], d_skip[j], norm_gated[j], w_out[j])
            zc = jnp.zeros((bp, D_CONV - 1, CONV_DIM), x_prompt.dtype)
            zs = jnp.zeros((bp, SSM_HEADS, SSM_HEADDIM, D_STATE), state_ssm.dtype)
            op, cp, sp = mamba_mixer(hp, zc, zs, *prm)
            osm, csm, ssm = mamba_mixer(hs, state_conv[j], state_ssm[j], *prm)
            conv_p.append(cp); ssm_p.append(sp)
            conv_s.append(csm); ssm_s.append(ssm)
        else:
            zb = jnp.zeros((bp, POOL_BUF, D_MODEL), x_prompt.dtype)
            op, pbp = pool_mixer(hp, zb, 0, w_pool[j], pool_scale[j])
            osm, pbs = pool_mixer(hs, state_pool[j], PAST_LEN, w_pool[j], pool_scale[j])
            pool_p.append(pbp); pool_s.append(pbs)
        xp = xp + op
        xs = xs + osm
        k_p, v_p = mem_kv(mem_prompt, norm_mem[i], w_xk[i], w_xv[i])
        mk_p.append(k_p); mv_p.append(v_p)
        xp = xp + cross_attn(rmsnorm(xp, norm_xattn[i]), k_p, v_p, w_xq[i], w_xo[i])
        xs = xs + cross_attn(rmsnorm(xs, norm_xattn[i]), cache_mem_k[i], cache_mem_v[i], w_xq[i], w_xo[i])
        xp = xp + sq_relu_mlp(rmsnorm(xp, norm_mlp[i]), w_up[i], w_down[i])
        xs = xs + sq_relu_mlp(rmsnorm(xs, norm_mlp[i]), w_up[i], w_down[i])
    y_prompt = rmsnorm(xp, norm_final)
    y_sample = rmsnorm(xs, norm_final)
    new_mem_k_p = jnp.stack(mk_p)
    new_mem_v_p = jnp.stack(mv_p)
    new_ssm_p = jnp.stack(ssm_p)
    new_conv_p = jnp.stack(conv_p)
    new_pool_p = jnp.stack(pool_p)
    new_ssm_s = jnp.stack(ssm_s)
    new_conv_s = jnp.stack(conv_s)
    new_pool_s = jnp.stack(pool_s)
    return (y_prompt, y_sample, new_mem_k_p, new_mem_v_p, new_ssm_p, new_conv_p, new_pool_p, new_ssm_s, new_conv_s, new_pool_s)
```

```cpp
#include <hip/hip_runtime.h>
#include <cstdio>
#include <cstdint>
__device__ __forceinline__ int opqv(int v) { asm volatile("" : "+v"(v)); return v; }
template <class P> __device__ __forceinline__ P* opqs(P* p) { asm volatile("" : "+s"(p)); return p; }
namespace pg8 {
#define PG8_LAS __attribute__((address_space(3)))
typedef unsigned short bf16_t;
typedef short bf16x8 __attribute__((ext_vector_type(8)));
typedef float f32x4 __attribute__((ext_vector_type(4)));
typedef unsigned u32x4 __attribute__((ext_vector_type(4)));
constexpr int BM = 256, BK = 64, HALF = 128, HTB = HALF * BK * 2  , STAGE_BYTES = 8 * HTB, NXCD = 8, WGM = 8;

__host__ __device__ __forceinline__ int lds_byte(int r, int c) { const int st = (r >> 4) * 2 + (c >> 5), rr = r & 15, cc = c & 31, ob = rr * 64 + cc * 2; return st * 1024 + (ob ^ (((ob >> 9) & 1) << 5)); }
__host__ __device__ __forceinline__ void stage_rc(int b, int& R, int& C) { const int st = b / 1024, sb = b % 1024, swz = sb ^ (((sb >> 9) & 1) << 5); R = (st >> 1) * 16 + swz / 64; C = (st & 1) * 32 + (swz % 64) / 2; }
__host__ __device__ __forceinline__ int perm32(int rho) { const int n = rho >> 4, i = rho & 15; return 8 * (i >> 2) + 4 * n + (i & 3); }

struct Unit { int pm, pn; };
struct Gemm { const bf16_t* A; const bf16_t* Bt; int M, N, K, lda, apn; };

struct StaticOrder {
    int nM, nN, nwg, G, c;
    __host__ __device__ void init(int M, int N, int G_, int c_) { nM = M / BM; nN = N / BM; nwg = nM * nN; G = G_; c = c_; }
    __host__ __device__ bool next(int i, Unit& u) const {
        const long L = (long)i * G + c; if (L >= nwg) return false;
        int wgid = (int)L; { const int q = nwg / NXCD, r = nwg % NXCD, xcd = wgid % NXCD, off = wgid / NXCD; wgid = (xcd < r ? xcd * (q + 1) : r * (q + 1) + (xcd - r) * q) + off; }
        const int nig = WGM * nN, gid = wgid / nig, fm = gid * WGM, gsz = (nM - fm) < WGM ? (nM - fm) : WGM;
        u.pm = fm + ((wgid % nig) % gsz); u.pn = (wgid % nig) / gsz; return true;
    }
    __device__ __forceinline__ void a_ready(const Unit&) const {}
    __device__ __forceinline__ void done(const Unit&) const {}
};

template <class Epi, class Sched, bool ALIGN_EPI = false, bool SP2 = false>
__device__ __forceinline__ void gemm_phase(PG8_LAS unsigned char* lds, const Gemm g, const Sched& S, const Epi& E) {
    const int tid = opqv((int)threadIdx.x), wid = __builtin_amdgcn_readfirstlane(tid >> 6), lane = tid & 63, wr = wid >> 2, wc = wid & 3, fr = lane & 15, fq = lane >> 4;
    const int K = g.K, nt = K / BK;
    unsigned voffA[2], voffB[2];
#pragma unroll
    for (int i = 0; i < 2; ++i) { int R, C; stage_rc(tid * 16 + i * 8192, R, C); const int Rb = Epi::PERM ? ((R & ~31) + perm32(R & 31)) : R;
        voffA[i] = (unsigned)(R * g.lda + C) * 2u; voffB[i] = (unsigned)(Rb * K + C) * 2u; }
    const size_t kstep = (size_t)(BK * 2);
    const size_t hstepA = (size_t)HALF * g.lda * 2, hstepB = (size_t)HALF * K * 2;
    const size_t tstepA = 2 * hstepA, tstepB = 2 * hstepB, apnb = (size_t)g.apn * 2;
    const unsigned ldsw = (unsigned)wid * 1024u;
    const int aoff = lds_byte(wr * 64 + fr, fq * 8), boff = lds_byte(wc * 32 + fr, fq * 8);
#define PG8_SA(b, h) (((b) * 2 + (h)) * HTB)
#define PG8_SB(b, h) ((4 + (b) * 2 + (h)) * HTB)
#define PG8_STAGE(bufoff, gbase, voff) do { _Pragma("unroll") for (int _i = 0; _i < 2; ++_i) \
        __builtin_amdgcn_global_load_lds((const unsigned*)((const char*)(gbase) + (voff)[_i]), (PG8_LAS unsigned*)(lds + (bufoff) + ldsw + _i * 8192), 16, 0, 0); } while (0)
#define PG8_LDA(dst, b, h) do { _Pragma("unroll") for (int m = 0; m < 4; ++m) _Pragma("unroll") for (int k = 0; k < 2; ++k) dst[m][k] = *(const PG8_LAS bf16x8*)(lds + PG8_SA(b, h) + aoff + m * 2048 + k * 1024); } while (0)
#define PG8_LDB(dst, b, h) do { _Pragma("unroll") for (int n = 0; n < 2; ++n) _Pragma("unroll") for (int k = 0; k < 2; ++k) dst[n][k] = *(const PG8_LAS bf16x8*)(lds + PG8_SB(b, h) + boff + n * 2048 + k * 1024); } while (0)
#define PG8_MMA(ai, bj, At, Bt) do { __builtin_amdgcn_s_setprio(1); _Pragma("unroll") for (int m = 0; m < 4; ++m) _Pragma("unroll") for (int n = 0; n < 2; ++n) _Pragma("unroll") for (int k = 0; k < 2; ++k) \
        acc[ai][bj][m][n] = __builtin_amdgcn_mfma_f32_16x16x32_bf16(Bt[n][k], At[m][k], acc[ai][bj][m][n], 0, 0, 0); __builtin_amdgcn_s_setprio(0); } while (0)
#define PG8_WAIT_V(n) asm volatile("s_waitcnt vmcnt(" #n ")" ::: "memory")
#define PG8_WAIT_L(n) asm volatile("s_waitcnt lgkmcnt(" #n ")" ::: "memory")
#define PG8_BAR __builtin_amdgcn_s_barrier()
#define PG8_SCHED __builtin_amdgcn_sched_barrier(0)
    Unit cur, nxt; int ui = 0;
    if (!S.next(0, cur)) return;
    f32x4 acc[2][2][4][2];
#pragma unroll
    for (int a = 0; a < 2; ++a)
#pragma unroll
        for (int b = 0; b < 2; ++b)
#pragma unroll
            for (int m = 0; m < 4; ++m)
#pragma unroll
                for (int n = 0; n < 2; ++n) acc[a][b][m][n] = (f32x4){0.f, 0.f, 0.f, 0.f};
    bf16x8 At[4][2], B0[2][2], B1[2][2];
    const char* cA = (const char*)g.A + (size_t)cur.pm * tstepA + (size_t)cur.pn * apnb; const char* cB = (const char*)g.Bt + (size_t)cur.pn * tstepB;
    S.a_ready(cur);
    if constexpr (SP2) {
        PG8_STAGE(PG8_SB(0, 0), cB, voffB); PG8_STAGE(PG8_SB(0, 1), cB + hstepB, voffB); PG8_STAGE(PG8_SA(0, 0), cA, voffA); PG8_STAGE(PG8_SA(0, 1), cA + hstepA, voffA);
        if (wr == 1) PG8_BAR;
        PG8_WAIT_V(2); PG8_BAR;
        PG8_STAGE(PG8_SB(1, 0), cB + kstep, voffB); PG8_STAGE(PG8_SA(1, 0), cA + kstep, voffA); PG8_STAGE(PG8_SB(1, 1), cB + hstepB + kstep, voffB);
        PG8_WAIT_V(6); PG8_BAR;
    } else {
        PG8_STAGE(PG8_SB(0, 0), cB, voffB); PG8_STAGE(PG8_SA(0, 0), cA, voffA); PG8_STAGE(PG8_SB(0, 1), cB + hstepB, voffB); PG8_STAGE(PG8_SA(0, 1), cA + hstepA, voffA);
        if (wr == 1) PG8_BAR;
        PG8_WAIT_V(4); PG8_BAR;
        PG8_STAGE(PG8_SB(1, 0), cB + kstep, voffB); PG8_STAGE(PG8_SA(1, 0), cA + kstep, voffA); PG8_STAGE(PG8_SB(1, 1), cB + hstepB + kstep, voffB);
        PG8_WAIT_V(6); PG8_BAR;
    }
    for (;;) {
        const bool has_next = S.next(ui + 1, nxt);
        const char* nA = has_next ? (const char*)g.A + (size_t)nxt.pm * tstepA + (size_t)nxt.pn * apnb : cA; const char* nB = has_next ? (const char*)g.Bt + (size_t)nxt.pn * tstepB : cB;
        for (int t = 0; t < nt; t += 2) {
            const bool last = (t == nt - 2);
            const char* a1 = cA + (size_t)(t + 1) * kstep;
            const char* a2 = last ? nA : cA + (size_t)(t + 2) * kstep; const char* b2 = last ? nB : cB + (size_t)(t + 2) * kstep;
            const char* a3 = a2 + kstep; const char* b3 = b2 + kstep;
            if (last && has_next) S.a_ready(nxt);
            if constexpr (SP2) {
            PG8_LDB(B0, 0, 0); PG8_LDB(B1, 0, 1); PG8_SCHED; PG8_LDA(At, 0, 0); PG8_STAGE(PG8_SA(1, 1), a1 + hstepA, voffA);
            PG8_WAIT_V(8); PG8_WAIT_L(0); PG8_BAR; PG8_MMA(0, 0, At, B0); PG8_MMA(0, 1, At, B1); PG8_BAR; PG8_SCHED;
            PG8_LDA(At, 0, 1); PG8_STAGE(PG8_SB(0, 0), b2, voffB); PG8_STAGE(PG8_SB(0, 1), b2 + hstepB, voffB); PG8_STAGE(PG8_SA(0, 0), a2, voffA);
            PG8_WAIT_V(8); PG8_WAIT_L(0); PG8_BAR; PG8_MMA(1, 0, At, B0); PG8_MMA(1, 1, At, B1); PG8_BAR; PG8_SCHED;
            PG8_LDB(B0, 1, 0); PG8_LDB(B1, 1, 1); PG8_SCHED; PG8_LDA(At, 1, 0); PG8_STAGE(PG8_SA(0, 1), a2 + hstepA, voffA);
            PG8_WAIT_V(8); PG8_WAIT_L(0); PG8_BAR; PG8_MMA(0, 0, At, B0); PG8_MMA(0, 1, At, B1); PG8_BAR; PG8_SCHED;
            PG8_LDA(At, 1, 1); PG8_STAGE(PG8_SB(1, 0), b3, voffB); PG8_STAGE(PG8_SB(1, 1), b3 + hstepB, voffB); PG8_STAGE(PG8_SA(1, 0), a3, voffA);
            PG8_WAIT_V(8); PG8_WAIT_L(0); PG8_BAR; PG8_MMA(1, 0, At, B0); PG8_MMA(1, 1, At, B1); PG8_BAR; PG8_SCHED;
            } else {
            PG8_LDB(B0, 0, 0); PG8_SCHED; PG8_LDA(At, 0, 0); PG8_STAGE(PG8_SA(1, 1), a1 + hstepA, voffA);
            PG8_WAIT_L(8); PG8_BAR; PG8_WAIT_L(0); PG8_MMA(0, 0, At, B0); PG8_BAR; PG8_SCHED;
            PG8_LDB(B1, 0, 1); PG8_STAGE(PG8_SB(0, 0), b2, voffB);
            PG8_BAR; PG8_WAIT_L(0); PG8_MMA(0, 1, At, B1); PG8_BAR;
            PG8_LDA(At, 0, 1); PG8_STAGE(PG8_SA(0, 0), a2, voffA);
            PG8_BAR; PG8_WAIT_L(0); PG8_MMA(1, 0, At, B0); PG8_BAR; PG8_SCHED;
            PG8_STAGE(PG8_SB(0, 1), b2 + hstepB, voffB);
            PG8_WAIT_V(6); PG8_BAR; PG8_MMA(1, 1, At, B1); PG8_BAR;
            PG8_LDB(B0, 1, 0); PG8_SCHED; PG8_LDA(At, 1, 0); PG8_STAGE(PG8_SA(0, 1), a2 + hstepA, voffA);
            PG8_WAIT_L(8); PG8_BAR; PG8_WAIT_L(0); PG8_MMA(0, 0, At, B0); PG8_BAR; PG8_SCHED;
            PG8_LDB(B1, 1, 1); PG8_STAGE(PG8_SB(1, 0), b3, voffB);
            PG8_BAR; PG8_WAIT_L(0); PG8_MMA(0, 1, At, B1); PG8_BAR;
            PG8_LDA(At, 1, 1); PG8_STAGE(PG8_SA(1, 0), a3, voffA);
            PG8_BAR; PG8_WAIT_L(0); PG8_MMA(1, 0, At, B0); PG8_BAR; PG8_SCHED;
            PG8_STAGE(PG8_SB(1, 1), b3 + hstepB, voffB);
            PG8_WAIT_V(6); PG8_BAR; PG8_MMA(1, 1, At, B1); PG8_BAR;
            }
        }
        if constexpr (ALIGN_EPI) { if (wr == 0) PG8_BAR; }
        if constexpr (!Epi::AFTER_DRAIN) { E(acc, cur, wr, wc, fr, fq); S.done(cur); }
        if (!has_next) break;
#pragma unroll
        for (int a = 0; a < 2; ++a)
#pragma unroll
            for (int b = 0; b < 2; ++b)
#pragma unroll
                for (int m = 0; m < 4; ++m)
#pragma unroll
                    for (int n = 0; n < 2; ++n) acc[a][b][m][n] = (f32x4){0.f, 0.f, 0.f, 0.f};
        cur = nxt; cA = nA; cB = nB; ++ui;
        if constexpr (ALIGN_EPI) { if (wr == 1) PG8_BAR; }
    }
    PG8_WAIT_V(0);
    if constexpr (!ALIGN_EPI) { if (wr == 0) PG8_BAR; }
    PG8_BAR;
    if constexpr (Epi::AFTER_DRAIN) { E.fused(acc, cur, wr, wc, fr, fq, lds, wid, lane); S.done(cur); }
#undef PG8_SA
#undef PG8_SB
#undef PG8_STAGE
#undef PG8_LDA
#undef PG8_LDB
#undef PG8_MMA
#undef PG8_WAIT_V
#undef PG8_WAIT_L
#undef PG8_BAR
#undef PG8_SCHED
}
}

#define LAS __attribute__((address_space(3)))
using pg8::bf16_t; using pg8::bf16x8; using pg8::f32x4; using pg8::u32x4; using pg8::Unit;
typedef unsigned u32x2 __attribute__((ext_vector_type(2)));
typedef float f32x2 __attribute__((ext_vector_type(2)));
typedef short s16x4 __attribute__((ext_vector_type(4)));
typedef short v4i16_t __attribute__((ext_vector_type(4)));

__device__ __forceinline__ unsigned pk(float lo, float hi) { unsigned r; asm("v_cvt_pk_bf16_f32 %0, %1, %2" : "=v"(r) : "v"(lo), "v"(hi)); return r; }
__device__ __forceinline__ float bflo(unsigned u) { return __uint_as_float(u << 16); }
__device__ __forceinline__ float bfhi(unsigned u) { return __uint_as_float(u & 0xffff0000u); }
__device__ __forceinline__ float fexp(float x) { return __builtin_amdgcn_exp2f(x * 1.4426950408889634f); }
__device__ __forceinline__ float silu_f(float v) { return v * __builtin_amdgcn_rcpf(1.0f + fexp(-v)); }
__device__ __forceinline__ float softplus_f(float v) { return v > 20.f ? v : log1pf(__expf(v)); }
__device__ __forceinline__ s16x4 lds_tr(LAS const unsigned char* p) { return __builtin_bit_cast(s16x4, __builtin_amdgcn_ds_read_tr16_b64_v4i16((LAS v4i16_t*)p)); }
__device__ __forceinline__ bf16x8 cat8(s16x4 lo, s16x4 hi) { return (bf16x8){lo[0], lo[1], lo[2], lo[3], hi[0], hi[1], hi[2], hi[3]}; }
__device__ __forceinline__ float wave_sum(float v) {
#pragma unroll
    for (int o = 1; o < 64; o <<= 1) v += __shfl_xor(v, o);
    return v;
}
__device__ __forceinline__ unsigned opq(unsigned v) { return v; }
#define LDS_WAIT() asm volatile("s_waitcnt lgkmcnt(0)" ::: "memory")
#define MFMA16(a, b, c) __builtin_amdgcn_mfma_f32_16x16x32_bf16((a), (b), (c), 0, 0, 0)

constexpr int TP = 16384, TSM = 1024, T = TP + TSM, DM = 1024;
constexpr int NZX = 6144, NINP = 6400, DIN = 2048, CONVD = 4096;
constexpr float EPS = 1e-5f;
constexpr float QSCALE = 0.0625f * 1.4426950408889634f;

__device__ __forceinline__ float row_rstd(const float* ssq, int row) {
    const f32x4* p = (const f32x4*)(ssq + (size_t)row * 16);
    const f32x4 a = p[0], b = p[1], c = p[2], d = p[3];
    const f32x4 s = (a + b) + (c + d);
    return rsqrtf(((s[0] + s[1]) + (s[2] + s[3])) * (1.0f / 1024.0f) + EPS);
}

constexpr int RSTD_TAB_OFF = 132096, RSTD_TAB_UNITS = 8;
template <class Sched> __device__ __forceinline__ void fill_rstd_table(LAS unsigned char* lds, const Sched& S, const float* ssq) {
    LAS float* tab = (LAS float*)(lds + RSTD_TAB_OFF);
    const int tid = opqv((int)threadIdx.x), r = tid >> 1, hf = tid & 1;
    pg8::Unit u;
    for (int i = 0; i < RSTD_TAB_UNITS && S.next(i, u); ++i) {
        const f32x4* p = (const f32x4*)(ssq + (size_t)(u.pm * 256 + r) * 16 + hf * 8);
        const f32x4 a = p[0], b = p[1]; const f32x4 sv = a + b;
        float t = (sv[0] + sv[1]) + (sv[2] + sv[3]); t += __shfl_xor(t, 1);
        if (hf == 0) tab[i * 256 + r] = rsqrtf(t * (1.0f / 1024.0f) + EPS);
    }
    __syncthreads();
}

struct EpiInProj {
    static constexpr bool PERM = true, AFTER_DRAIN = false;
    bf16_t* ZX; float* DT; LAS const float* tab; mutable int ui;
    __device__ __forceinline__ void operator()(const f32x4 (&acc)[2][2][4][2], const Unit& u, int wr, int wc, int fr, int fq) const {
        const int row0 = u.pm * 256 + wr * 64 + fr;
        const bool last = (u.pn == 24);
        LAS const float* tb = tab + ui * 256 + wr * 64 + fr; ++ui;
        if (last && wc != 0) return;
#pragma unroll
        for (int ai = 0; ai < 2; ++ai)
#pragma unroll
            for (int m = 0; m < 4; ++m) {
                const int row = row0 + ai * 128 + m * 16;
                const float r = tb[ai * 128 + m * 16];
                if (!last) {
                    bf16_t* rowp = ZX + (size_t)row * NZX + u.pn * 256 + wc * 32 + 8 * fq;
#pragma unroll
                    for (int bj = 0; bj < 2; ++bj) {
                        const f32x4 v0 = acc[ai][bj][m][0] * r, v1 = acc[ai][bj][m][1] * r;
                        u32x4 w; w.x = pk(v0[0], v0[1]); w.y = pk(v0[2], v0[3]); w.z = pk(v1[0], v1[1]); w.w = pk(v1[2], v1[3]);
                        *(u32x4*)(rowp + bj * 128) = w;
                    }
                } else {
                    float* dp = DT + (size_t)row * 32 + 8 * fq;
                    *(f32x4*)(dp) = acc[ai][0][m][0] * r; *(f32x4*)(dp + 4) = acc[ai][0][m][1] * r;
                }
                asm volatile("" ::: "memory");
            }
    }
};

template <int ACT> struct EpiScaleBf16 {
    static constexpr bool PERM = true, AFTER_DRAIN = false;
    bf16_t* O; int ldc; LAS const float* tab; mutable int ui;
    __device__ __forceinline__ void operator()(const f32x4 (&acc)[2][2][4][2], const Unit& u, int wr, int wc, int fr, int fq) const {
        const int row0 = u.pm * 256 + wr * 64 + fr;
        LAS const float* tb = tab + ui * 256 + wr * 64 + fr; ++ui;
#pragma unroll
        for (int ai = 0; ai < 2; ++ai)
#pragma unroll
            for (int m = 0; m < 4; ++m) {
                const int row = row0 + ai * 128 + m * 16;
                const float r = tb[ai * 128 + m * 16];
                bf16_t* rowp = O + (size_t)row * ldc + u.pn * 256 + wc * 32 + 8 * fq;
#pragma unroll
                for (int bj = 0; bj < 2; ++bj) {
                    f32x4 v0 = acc[ai][bj][m][0] * r, v1 = acc[ai][bj][m][1] * r;
                    if (ACT == 1) {
#pragma unroll
                        for (int j = 0; j < 4; ++j) { const float a0 = fmaxf(v0[j], 0.f), a1 = fmaxf(v1[j], 0.f); v0[j] = a0 * a0; v1[j] = a1 * a1; }
                    }
                    u32x4 w; w.x = pk(v0[0], v0[1]); w.y = pk(v0[2], v0[3]); w.z = pk(v1[0], v1[1]); w.w = pk(v1[2], v1[3]);
                    *(u32x4*)(rowp + bj * 128) = w;
                }
                asm volatile("" ::: "memory");
            }
    }
};

struct EpiMemKV {
    static constexpr bool PERM = true, AFTER_DRAIN = false;
    float* outK; const float* rstd; int layer; bf16_t* kvb;
    __device__ __forceinline__ void operator()(const f32x4 (&acc)[2][2][4][2], const Unit& u, int wr, int wc, int fr, int fq) const {
        const int row0 = u.pm * 256 + wr * 64 + fr;
        float* base = outK + (size_t)((u.pn >> 2) & 1) * 4194304 + (size_t)layer * (2048 * 1024) + (u.pn & 3) * 256 + wc * 32 + 8 * fq;
#pragma unroll
        for (int ai = 0; ai < 2; ++ai)
#pragma unroll
            for (int m = 0; m < 4; ++m) {
                const int row = row0 + ai * 128 + m * 16;
                const float r = rstd[row];
                float* rowp = base + (size_t)row * 1024;
                bf16_t* rowb = kvb + ((size_t)(layer * 2 + ((u.pn >> 2) & 1)) * 2048 + row) * 1024 + (u.pn & 3) * 256 + wc * 32 + 8 * fq;
#pragma unroll
                for (int bj = 0; bj < 2; ++bj) {
                    const f32x4 v0 = acc[ai][bj][m][0] * r, v1 = acc[ai][bj][m][1] * r;
                    *(f32x4*)(rowp + bj * 128) = v0; *(f32x4*)(rowp + bj * 128 + 4) = v1;
                    u32x4 wv; wv.x = pk(v0[0], v0[1]); wv.y = pk(v0[2], v0[3]); wv.z = pk(v1[0], v1[1]); wv.w = pk(v1[2], v1[3]);
                    *(u32x4*)(rowb + bj * 128) = wv;
                }
                asm volatile("" ::: "memory");
            }
    }
};

struct EpiResid {
    static constexpr bool PERM = false, AFTER_DRAIN = false;
    const float* base_p; const float* base_s; float* X; bf16_t* XB; float* ssq;
    __device__ __forceinline__ void operator()(const f32x4 (&acc)[2][2][4][2], const Unit& u, int wr, int wc, int fr, int fq) const {
        const float* base = base_p + ((u.pm < 64) ? (ptrdiff_t)0 : (base_s - base_p));
        const int row0 = u.pm * 256 + wr * 64 + fr, col0 = u.pn * 256 + wc * 32 + 4 * fq;
        f32x4 nb[2][2];
#pragma unroll
        for (int bj = 0; bj < 2; ++bj)
#pragma unroll
            for (int n = 0; n < 2; ++n) nb[bj][n] = *(const f32x4*)(base + (size_t)row0 * 1024 + col0 + bj * 128 + n * 16);
#pragma unroll
        for (int ai = 0; ai < 2; ++ai)
#pragma unroll
            for (int m = 0; m < 4; ++m) {
                const int row = row0 + ai * 128 + m * 16;
                const size_t off = (size_t)row * 1024 + col0;
                f32x4 cb[2][2];
#pragma unroll
                for (int bj = 0; bj < 2; ++bj)
#pragma unroll
                    for (int n = 0; n < 2; ++n) cb[bj][n] = nb[bj][n];
                if (ai * 4 + m < 7) { const int rn = ai * 4 + m + 1; const size_t offn = (size_t)(row0 + (rn >> 2) * 128 + (rn & 3) * 16) * 1024 + col0;
#pragma unroll
                    for (int bj = 0; bj < 2; ++bj)
#pragma unroll
                        for (int n = 0; n < 2; ++n) nb[bj][n] = *(const f32x4*)(base + offn + bj * 128 + n * 16); }
                float s = 0.f;
#pragma unroll
                for (int bj = 0; bj < 2; ++bj)
#pragma unroll
                    for (int n = 0; n < 2; ++n) {
                        const f32x4 b = cb[bj][n];
                        const f32x4 x = b + acc[ai][bj][m][n];
                        s += (x[0] * x[0] + x[1] * x[1]) + (x[2] * x[2] + x[3] * x[3]);
                        *(f32x4*)(X + off + bj * 128 + n * 16) = x;
                        if (XB) { u32x2 w; w.x = pk(x[0], x[1]); w.y = pk(x[2], x[3]);
                        *(u32x2*)(XB + off + bj * 128 + n * 16) = w; }
                    }
                s += __shfl_xor(s, 16); s += __shfl_xor(s, 32);
                if (fq == 0) ssq[(size_t)row * 16 + u.pn * 4 + wc] = s;
                asm volatile("" ::: "memory");
            }
    }
};

constexpr size_t MiB = 1u << 20;
constexpr size_t WS_CTL = 0, CTL_ZERO_BYTES = 32768;
constexpr size_t WS_WIN = 1 * MiB, WS_WOUT = 14 * MiB, WS_WQ = 18 * MiB, WS_WKV = 22 * MiB, WS_WO = 30 * MiB, WS_WUP = 34 * MiB, WS_WDN = 50 * MiB, WS_WPOOL = 66 * MiB;
constexpr size_t WS_MEMB = 67 * MiB, WS_MEMR = 71 * MiB, WS_SSQ = 72 * MiB, WS_SSQH = 74 * MiB, WS_DT = 77 * MiB;
constexpr size_t WS_XB = 80 * MiB, WS_QB = 114 * MiB, WS_OB = 148 * MiB, WS_YG = 182 * MiB, WS_ZX = 250 * MiB, WS_ACT = 454 * MiB, WS_HB = 590 * MiB, WS_KVB = 726 * MiB, WS_END = 742 * MiB;
constexpr size_t OUT_X = 0, OUT_MK = 17825792, OUT_MV = 22020096, OUT_SSMP = 26214400, OUT_CONVP = 28311552, OUT_POOLP = 28409856, OUT_SSMS = 28532736, OUT_CONVS = 62087168, OUT_POOLS = 63660032, OUT_TOTAL = 65626112;

constexpr int NWAVES = 8, NTHR = 512;
constexpr int RING_BYTES = 131072, LDS_BYTES = 153600 + 256, MISC_OFF = 150 * 1024;
constexpr int CW_BAR = 4096;

#define XB_TMO      128
#define XB_XCNT(j)  (256  + 64 * (j))
#define XB_XSUB(j)  (1280 + 64 * (j))
#define XB_XGEN(j)  (2304 + 64 * (j))
#define XB_TOP      3328
#define XB_TOPGEN   3392
#define XCD_BAR_WORDS 3456
#define XB_SPIN_CAP (1u << 18)
__device__ __forceinline__ unsigned xb_ld(unsigned* p)              { return __hip_atomic_load(p, __ATOMIC_RELAXED, __HIP_MEMORY_SCOPE_AGENT); }
__device__ __forceinline__ unsigned xb_add(unsigned* p, unsigned v) { return __hip_atomic_fetch_add(p, v, __ATOMIC_RELAXED, __HIP_MEMORY_SCOPE_AGENT); }
__device__ __forceinline__ unsigned xb_xcc_id() { return (unsigned)__builtin_amdgcn_s_getreg((3 << 11) | 20) & 0xFu; }
#define XB_SPIN(cond, bar) do { unsigned _sp = 0; while (cond) { __builtin_amdgcn_s_sleep(1); \
    if ((++_sp & 255u) == 0u) { if (xb_ld(&(bar)[XB_TMO])) break; if (_sp > XB_SPIN_CAP) { atomicAdd(&(bar)[XB_TMO], 1u); break; } } } } while (0)
struct XcdBarrier { unsigned* bar; unsigned x; volatile LAS unsigned* st; };
__device__ __forceinline__ XcdBarrier xcd_barrier_post(unsigned* bar, volatile LAS unsigned* st) {
    XcdBarrier b; b.bar = bar; b.x = xb_xcc_id(); b.st = st;
    if (threadIdx.x == 0) (void)xb_add(&bar[XB_XCNT(b.x)], 1u);
    return b;
}
__device__ __forceinline__ void xcd_barrier_complete(unsigned* bar, unsigned x, unsigned& nloc, unsigned& nx) {
    const unsigned G = gridDim.x * gridDim.y * gridDim.z;
    unsigned sum, cnt, mine, sp = 0u;
    for (;;) {
        sum = 0u; cnt = 0u; mine = 0u;
#pragma unroll
        for (unsigned j = 0; j < 16; ++j) { const unsigned c = xb_ld(&bar[XB_XCNT(j)]); sum += c; cnt += (c > 0u) ? 1u : 0u; mine = (j == x) ? c : mine; }
        if (sum == G) break;
        __builtin_amdgcn_s_sleep(1);
        if ((++sp & 255u) == 0u) { if (xb_ld(&bar[XB_TMO])) break; if (sp > XB_SPIN_CAP) { atomicAdd(&bar[XB_TMO], 1u); break; } }
    }
    nloc = mine > 0u ? mine : 1u; nx = cnt > 0u ? cnt : 1u;
}
__device__ __forceinline__ void xcd_barrier(const XcdBarrier& b) {
    asm volatile("s_waitcnt vmcnt(0)" ::: "memory");
    __syncthreads();
    if (threadIdx.x == 0) {
        unsigned* bar = b.bar;
        __builtin_amdgcn_s_waitcnt(0);
        unsigned nloc = b.st[0], nx = b.st[1];
        if (nloc == 0u) { xcd_barrier_complete(bar, b.x, nloc, nx); b.st[0] = nloc; b.st[1] = nx; }
        const unsigned old = xb_add(&bar[XB_XSUB(b.x)], 1u);
        const unsigned gen = old / nloc;
        if (old + 1u == (gen + 1u) * nloc) {
            __builtin_amdgcn_fence(__ATOMIC_RELEASE, "agent");
            asm volatile("s_waitcnt vmcnt(0)" ::: "memory");
            const unsigned og = xb_add(&bar[XB_TOP], 1u);
            const unsigned tg = og / nx;
            if (og + 1u == (tg + 1u) * nx) xb_add(&bar[XB_TOPGEN], 1u);
            else XB_SPIN(xb_ld(&bar[XB_TOPGEN]) == tg, bar);
            __builtin_amdgcn_fence(__ATOMIC_ACQUIRE, "agent");
            xb_add(&bar[XB_XGEN(b.x)], 1u);
            asm volatile("s_waitcnt vmcnt(0)" ::: "memory");
        } else {
            XB_SPIN(xb_ld(&bar[XB_XGEN(b.x)]) == gen, bar);
            __builtin_amdgcn_fence(__ATOMIC_ACQUIRE, "agent");
            asm volatile("s_waitcnt vmcnt(0)" ::: "memory");
        }
    }
    __syncthreads();
}

struct Args { const float* in[29]; float* out; unsigned char* ws; int ph_lo, ph_hi; };
static_assert(sizeof(Args) == 31 * 8 + 8, "no padding in Args");
struct Ctx {
    LAS unsigned char* lds; unsigned char* ws; float* out;
    int tid, lane, wave, G, bid;
};
typedef const float* fptr_t;
__device__ __forceinline__ const float* karg_in(int i) {
    const __attribute__((address_space(4))) char* p = (const __attribute__((address_space(4))) char*)__builtin_amdgcn_kernarg_segment_ptr();
    asm volatile("" : "+s"(p));
    return *(const __attribute__((address_space(4))) fptr_t*)(p + 8 * i);
}
#define INP(i) karg_in(i)

__device__ __forceinline__ void transpose_item(const float* W, int K, int N, bf16_t* WT, int row_off, const float* gk, const float* gn, float cs, LAS float* scr, int item, int lane) {
    const int nblk = (N + 63) / 64, kb = item / nblk, nb = item - kb * nblk, k0 = 64 * kb, n0 = 64 * nb;
    const int n4 = (lane & 15) * 4; const bool nok = (n0 + n4) < N;
    f32x4 v[16];
#pragma unroll
    for (int i = 0; i < 16; ++i) { const int kk = 4 * i + (lane >> 4); v[i] = nok ? *(const f32x4*)(W + (size_t)(k0 + kk) * N + n0 + n4) : (f32x4){0.f, 0.f, 0.f, 0.f}; }
#pragma unroll
    for (int i = 0; i < 16; ++i) { const int kk = 4 * i + (lane >> 4); const float gs = gk ? gk[k0 + kk] : 1.f; LAS float* d = scr + kk * 65 + n4;
        d[0] = v[i][0] * gs; d[1] = v[i][1] * gs; d[2] = v[i][2] * gs; d[3] = v[i][3] * gs; }
    LDS_WAIT();
    const int c = lane & 7;
#pragma unroll
    for (int j = 0; j < 8; ++j) { const int n = (lane >> 3) + 8 * j; const LAS float* s = scr + (8 * c) * 65 + n; const float sc = (gn && (n0 + n) < N) ? cs * gn[n0 + n] : cs;
        u32x4 o; o.x = pk(s[0 * 65] * sc, s[1 * 65] * sc); o.y = pk(s[2 * 65] * sc, s[3 * 65] * sc); o.z = pk(s[4 * 65] * sc, s[5 * 65] * sc); o.w = pk(s[6 * 65] * sc, s[7 * 65] * sc);
        *(u32x4*)(WT + (size_t)(row_off + n0 + n) * K + k0 + 8 * c) = o; }
    LDS_WAIT();
}
__device__ __forceinline__ float row_to_bf16(const float* xrow, bf16_t* orow, int lane) {
    const f32x4* xr = (const f32x4*)xrow + lane; u32x2* o8 = (u32x2*)orow + lane;
    float s = 0.f;
#pragma unroll
    for (int j = 0; j < 4; ++j) { const f32x4 v = xr[64 * j]; s += (v[0] * v[0] + v[1] * v[1]) + (v[2] * v[2] + v[3] * v[3]); u32x2 w; w.x = pk(v[0], v[1]); w.y = pk(v[2], v[3]); o8[64 * j] = w; }
    return wave_sum(s);
}
template <int SET>
__device__ __forceinline__ void convert_weights(Ctx& C, int gw, int NGW) {
    LAS float* scr = (LAS float*)(C.lds + C.wave * 17408);
    unsigned char* ws = C.ws;
    constexpr int I_IN = 16 * 97, I_OUT = 32 * 16, I_SQ = 16 * 16, I_UP = 16 * 64, I_DN = 64 * 16, I_PL = 4 * 4;
    constexpr int NITEMS = SET == 0 ? I_IN + I_OUT + I_SQ + 4 * I_SQ + I_SQ : (SET == 1 ? I_SQ + I_SQ + I_UP + I_DN + 4 * I_PL + I_DN : I_UP);
    for (int it = gw; it < NITEMS; it += NGW) {
        int r = it; const float* W; int K, N, roff = 0; bf16_t* WT; const float* gk = nullptr; const float* gn = nullptr; float cs = 1.f;
        if (SET == 0) {
            if (r < I_IN) { W = INP(13); K = 1024; N = 6176; WT = (bf16_t*)(ws + WS_WIN); gk = INP(8); }
            else if ((r -= I_IN) < I_OUT) { W = INP(20); K = 2048; N = 1024; WT = (bf16_t*)(ws + WS_WOUT); gk = INP(19); }
            else if ((r -= I_OUT) < I_SQ) { W = INP(23); K = 1024; N = 1024; WT = (bf16_t*)(ws + WS_WQ); gk = INP(9); cs = QSCALE; }
            else if ((r -= I_SQ) < 4 * I_SQ) { const int i = r / I_SQ; r -= i * I_SQ; const int ly = i >> 1, kv = i & 1; W = (kv ? INP(25) : INP(24)) + (size_t)ly * 1048576; K = 1024; N = 1024; WT = (bf16_t*)(ws + WS_WKV); roff = i * 1024; gk = INP(10) + ly * 1024; }
            else { r -= 4 * I_SQ; W = INP(26); K = 1024; N = 1024; WT = (bf16_t*)(ws + WS_WO); }
        } else if (SET == 2) {
            W = INP(27); K = 1024; N = 4096; WT = (bf16_t*)(ws + WS_WUP); gk = INP(11);
        } else {
            if (r < I_SQ) { W = INP(23) + 1048576; K = 1024; N = 1024; WT = (bf16_t*)(ws + WS_WQ) + 1048576; gk = INP(9) + 1024; cs = QSCALE; }
            else if ((r -= I_SQ) < I_SQ) { W = INP(26) + 1048576; K = 1024; N = 1024; WT = (bf16_t*)(ws + WS_WO) + 1048576; }
            else if ((r -= I_SQ) < I_UP) { W = INP(27) + 4194304; K = 1024; N = 4096; WT = (bf16_t*)(ws + WS_WUP) + 4194304; gk = INP(11) + 1024; }
            else if ((r -= I_UP) < I_DN) { W = INP(28) + 4194304; K = 4096; N = 1024; WT = (bf16_t*)(ws + WS_WDN) + 4194304; }
            else if ((r -= I_DN) < 4 * I_PL) { const int i = r / I_PL; r -= i * I_PL; W = INP(21) + (size_t)i * 65536; K = 256; N = 256; WT = (bf16_t*)(ws + WS_WPOOL); roff = i * 256; gn = INP(22) + i * 256; }
            else { r -= 4 * I_PL; W = INP(28); K = 4096; N = 1024; WT = (bf16_t*)(ws + WS_WDN); }
        }
        transpose_item(W, K, N, WT, roff, gk, gn, cs, scr, r, opqv(C.tid) & 63);
    }
}
__device__ __forceinline__ void p_prologue(Ctx& C) {
    const int gw = C.bid * NWAVES + C.wave, NGW = C.G * NWAVES;
    unsigned char* ws = C.ws;
    convert_weights<0>(C, gw, NGW);
    { u32x4* z = (u32x4*)((bf16_t*)(ws + WS_WIN) + (size_t)6176 * 1024); const int n16 = (NINP - 6176) * 1024 * 2 / 16;
      for (int i = C.bid * NTHR + C.tid; i < n16; i += C.G * NTHR) z[i] = (u32x4){0u, 0u, 0u, 0u}; }
    bf16_t* XB = (bf16_t*)(ws + WS_XB); float* ssq = (float*)(ws + WS_SSQ);
    const float* xp_ = INP(0); const float* xs_ = INP(1) - (size_t)TP * 1024; const float* mem_ = INP(7);
    for (int m = gw; m < T; m += 2 * NGW) {
        const int m2 = m + NGW; const bool two = m2 < T;
        const f32x4* xr = (const f32x4*)((m < TP ? xp_ : xs_) + (size_t)m * 1024) + C.lane;
        const f32x4* xr2 = (const f32x4*)((m2 < TP ? xp_ : xs_) + (size_t)(two ? m2 : m) * 1024) + C.lane;
        f32x4 va[4], vb[4];
#pragma unroll
        for (int j = 0; j < 4; ++j) { va[j] = xr[64 * j]; vb[j] = xr2[64 * j]; }
        float s1 = 0.f, s2 = 0.f; u32x2* o1 = (u32x2*)(XB + (size_t)m * 1024) + C.lane; u32x2* o2 = (u32x2*)(XB + (size_t)(two ? m2 : m) * 1024) + C.lane;
#pragma unroll
        for (int j = 0; j < 4; ++j) { s1 += (va[j][0] * va[j][0] + va[j][1] * va[j][1]) + (va[j][2] * va[j][2] + va[j][3] * va[j][3]); u32x2 wv; wv.x = pk(va[j][0], va[j][1]); wv.y = pk(va[j][2], va[j][3]); o1[64 * j] = wv; }
        s1 = wave_sum(s1);
        if (C.lane < 16) ssq[(size_t)m * 16 + C.lane] = (C.lane == 0) ? s1 : 0.f;
        if (two) {
#pragma unroll
            for (int j = 0; j < 4; ++j) { s2 += (vb[j][0] * vb[j][0] + vb[j][1] * vb[j][1]) + (vb[j][2] * vb[j][2] + vb[j][3] * vb[j][3]); u32x2 wv; wv.x = pk(vb[j][0], vb[j][1]); wv.y = pk(vb[j][2], vb[j][3]); o2[64 * j] = wv; }
            s2 = wave_sum(s2);
            if (C.lane < 16) ssq[(size_t)m2 * 16 + C.lane] = (C.lane == 0) ? s2 : 0.f;
        }
    }
    bf16_t* MEMB = (bf16_t*)(ws + WS_MEMB); float* memr = (float*)(ws + WS_MEMR);
    for (int m = gw; m < 2048; m += NGW) {
        const float s = row_to_bf16(mem_ + (size_t)m * 1024, MEMB + (size_t)m * 1024, C.lane);
        if (C.lane == 0) memr[m] = rsqrtf(s * (1.0f / 1024.0f) + EPS);
    }
}

__device__ __forceinline__ void p_conv(Ctx& C) {
    const bf16_t* ZX = (const bf16_t*)(C.ws + WS_ZX); bf16_t* ACT = (bf16_t*)(C.ws + WS_ACT);
    const int gt = C.bid * NTHR + C.tid, NT = C.G * NTHR;
    const int oct = gt & 511, ch0 = oct * 8;
    float w[4][8], bias[8];
    const float* cw_ = INP(14); const float* cb_ = INP(15); const float* cst_ = INP(5);
#pragma unroll
    for (int k = 0; k < 4; ++k)
#pragma unroll
        for (int i = 0; i < 8; ++i) w[k][i] = cw_[k * CONVD + ch0 + i];
#pragma unroll
    for (int i = 0; i < 8; ++i) bias[i] = cb_[ch0 + i];
    for (int id = gt; id < (T / 8) * 512; id += NT) {
        const int sidx = id >> 9, m0 = sidx * 8;
        float h0[8], h1[8], h2[8];
        if (m0 < TP) {
            if ((m0 & 2047) == 0) {
#pragma unroll
                for (int i = 0; i < 8; ++i) { h0[i] = 0.f; h1[i] = 0.f; h2[i] = 0.f; }
            } else {
                const u32x4 a = *(const u32x4*)(ZX + (size_t)(m0 - 3) * NZX + 2048 + ch0), b = *(const u32x4*)(ZX + (size_t)(m0 - 2) * NZX + 2048 + ch0), c = *(const u32x4*)(ZX + (size_t)(m0 - 1) * NZX + 2048 + ch0);
#pragma unroll
                for (int i = 0; i < 4; ++i) { h0[2 * i] = bflo(a[i]); h0[2 * i + 1] = bfhi(a[i]); h1[2 * i] = bflo(b[i]); h1[2 * i + 1] = bfhi(b[i]); h2[2 * i] = bflo(c[i]); h2[2 * i + 1] = bfhi(c[i]); }
            }
        } else {
            const float* cs = cst_ + (size_t)((m0 - TP) >> 3) * 3 * CONVD + ch0;
#pragma unroll
            for (int i = 0; i < 8; ++i) { h0[i] = cs[i]; h1[i] = cs[CONVD + i]; h2[i] = cs[2 * CONVD + i]; }
        }
        u32x4 cur[8];
#pragma unroll
        for (int t = 0; t < 8; ++t) cur[t] = __builtin_nontemporal_load((const u32x4*)(ZX + (size_t)(m0 + t) * NZX + 2048 + ch0));
#pragma unroll
        for (int t = 0; t < 8; ++t) {
            float x[8], o[8];
#pragma unroll
            for (int i = 0; i < 4; ++i) { x[2 * i] = bflo(cur[t][i]); x[2 * i + 1] = bfhi(cur[t][i]); }
#pragma unroll
            for (int i = 0; i < 8; ++i) { const float v = bias[i] + w[0][i] * h0[i] + w[1][i] * h1[i] + w[2][i] * h2[i] + w[3][i] * x[i]; o[i] = silu_f(v); h0[i] = h1[i]; h1[i] = h2[i]; h2[i] = x[i]; }
            u32x4 ov; ov.x = pk(o[0], o[1]); ov.y = pk(o[2], o[3]); ov.z = pk(o[4], o[5]); ov.w = pk(o[6], o[7]);
            *(u32x4*)(ACT + (size_t)(m0 + t) * CONVD + ch0) = ov;
        }
    }
}

constexpr int PC = 288, PX = 160;
constexpr int SP_CM = 0, SP_BM = 36864, SP_XS = 73728, SP_XW = 94208, SP_HP = 114688, SP_DTV = 133120, SP_ACS = 141312;
#ifndef SSD_PREFETCH
#define SSD_PREFETCH 1
#endif
__device__ __forceinline__ void ssd_prompt_unit(Ctx& C, int b, int h) {
    LAS unsigned char* lds = C.lds;
    const int w = C.wave, g = h >> 2;
    const bf16_t* ACT = (const bf16_t*)(C.ws + WS_ACT); const bf16_t* ZX = (const bf16_t*)(C.ws + WS_ZX); const float* DT = (const float*)(C.ws + WS_DT);
    bf16_t* YG = (bf16_t*)(C.ws + WS_YG); float* SSQH = (float*)(C.ws + WS_SSQH);
    const float a = -__expf(INP(17)[h]), dtb = INP(16)[h], dsk = INP(18)[h];
    LAS float* dtv = (LAS float*)(lds + SP_DTV); LAS float* acs = (LAS float*)(lds + SP_ACS);
    f32x4 hacc[4];
#pragma unroll
    for (int pt = 0; pt < 4; ++pt) hacc[pt] = (f32x4){0.f, 0.f, 0.f, 0.f};
    for (int i = C.tid; i < 64 * PC / 16; i += NTHR) *(LAS u32x4*)(lds + SP_HP + i * 16) = (u32x4){0u, 0u, 0u, 0u};
    {
        const int t4 = C.tid * 4, lane = C.lane; float d[4], cs[4]; float run = 0.f;
#pragma unroll
        for (int i = 0; i < 4; ++i) { d[i] = softplus_f(DT[(size_t)(b * 2048 + t4 + i) * 32 + h] + dtb); run += d[i] * a; cs[i] = run; }
        float ps = run;
#pragma unroll
        for (int o = 1; o < 32; o <<= 1) { const float t = __shfl_up(ps, o, 32); if ((lane & 31) >= o) ps += t; }
        const float ex = ps - run;
        *(LAS f32x4*)(dtv + t4) = (f32x4){d[0], d[1], d[2], d[3]}; *(LAS f32x4*)(acs + t4) = (f32x4){ex + cs[0], ex + cs[1], ex + cs[2], ex + cs[3]};
    }
    __syncthreads();
    int l16 = 0, kq = 0;
    u32x4 v[10]; u32x2 zv[4];
#define SSD_LOAD(cn) do { const int row0n = b * 2048 + (cn) * 128; \
        _Pragma("unroll") for (int k = 0; k < 2; ++k) { const int id = tid + 512 * k; v[k] = *(const u32x4*)(ACT + (size_t)(row0n + (id >> 3)) * CONVD + h * 64 + (id & 7) * 8); } \
        _Pragma("unroll") for (int k = 0; k < 4; ++k) { const int id = tid + 512 * k; v[2 + k] = *(const u32x4*)(ACT + (size_t)(row0n + (id >> 4)) * CONVD + 2048 + g * 128 + (id & 15) * 8); \
                                                         v[6 + k] = *(const u32x4*)(ACT + (size_t)(row0n + (id >> 4)) * CONVD + 3072 + g * 128 + (id & 15) * 8); } \
        _Pragma("unroll") for (int pt = 0; pt < 4; ++pt) zv[pt] = *(const u32x2*)(ZX + (size_t)(row0n + 16 * w + l16) * NZX + h * 64 + 16 * pt + 4 * kq); } while (0)
#pragma unroll 1
    for (int c = 0; c < 16; ++c) {
        const int tid = opqv(C.tid), lane = tid & 63; l16 = lane & 15; kq = lane >> 4;
        const int row0 = b * 2048 + c * 128;
        LAS const float* dtc = dtv + c * 128; LAS const float* acc_ = acs + c * 128;
        const float aend = acc_[127];
        if (!SSD_PREFETCH || c == 0) SSD_LOAD(c);
        u32x2 zc[4];
#pragma unroll
        for (int pt = 0; pt < 4; ++pt) zc[pt] = zv[pt];
#pragma unroll
        for (int k = 0; k < 2; ++k) { const int id = tid + 512 * k, s = id >> 3, cc = id & 7;
            *(LAS u32x4*)(lds + SP_XS + s * PX + cc * 16) = v[k];
            const float ws_ = dtc[s] * fexp(aend - acc_[s]); u32x4 o;
#pragma unroll
            for (int i = 0; i < 4; ++i) o[i] = pk(bflo(v[k][i]) * ws_, bfhi(v[k][i]) * ws_);
            *(LAS u32x4*)(lds + SP_XW + s * PX + cc * 16) = o; }
#pragma unroll
        for (int k = 0; k < 4; ++k) { const int id = tid + 512 * k, s = id >> 4, cc = id & 15;
            *(LAS u32x4*)(lds + SP_BM + s * PC + cc * 16) = v[2 + k]; *(LAS u32x4*)(lds + SP_CM + s * PC + cc * 16) = v[6 + k]; }
        __syncthreads();
        if (SSD_PREFETCH && c + 1 < 16) SSD_LOAD(c + 1);
        f32x4 cb[8];
        {
            bf16x8 bfr[4];
#pragma unroll
            for (int ks = 0; ks < 4; ++ks) bfr[ks] = *(LAS bf16x8*)(lds + SP_CM + (16 * w + l16) * PC + 16 * kq + 64 * ks);
#pragma unroll
            for (int st = 0; st < 8; ++st) { f32x4 acc = (f32x4){0.f, 0.f, 0.f, 0.f};
#pragma unroll
                for (int ks = 0; ks < 4; ++ks) { const bf16x8 af = *(LAS bf16x8*)(lds + SP_BM + (16 * st + l16) * PC + 16 * kq + 64 * ks); acc = MFMA16(af, bfr[ks], acc); }
                cb[st] = acc; }
        }
        {
            const float dec = fexp(aend);
#pragma unroll
            for (int pt = 0; pt < 4; ++pt) hacc[pt] = hacc[pt] * dec;
#pragma unroll
            for (int ks = 0; ks < 4; ++ks) {
                const int srow = 32 * ks + 4 * kq + (l16 >> 2);
                const LAS unsigned char* ap = lds + SP_BM + srow * PC + (16 * w + 4 * (l16 & 3)) * 2;
                const bf16x8 af = cat8(lds_tr(ap), lds_tr(ap + 16 * PC));
                const LAS unsigned char* bp = lds + SP_XW + srow * PX + (4 * (l16 & 3)) * 2;
#pragma unroll
                for (int pt = 0; pt < 4; ++pt) { const bf16x8 bf = cat8(lds_tr(bp + 32 * pt), lds_tr(bp + 32 * pt + 16 * PX)); hacc[pt] = MFMA16(af, bf, hacc[pt]); }
            }
        }
        const int l = 16 * w + l16; const float al = acc_[l];
        bf16x8 mp[4];
#pragma unroll
        for (int ks = 0; ks < 4; ++ks) { u32x4 pw;
#pragma unroll
            for (int hh = 0; hh < 2; ++hh) { const int st = 2 * ks + hh, s0 = 16 * st + 4 * kq; const f32x4 as4 = *(LAS const f32x4*)(acc_ + s0), dt4 = *(LAS const f32x4*)(dtc + s0); float mv[4];
#pragma unroll
                for (int j = 0; j < 4; ++j) mv[j] = (s0 + j <= l) ? cb[st][j] * fexp(al - as4[j]) * dt4[j] : 0.f;
                pw[2 * hh] = pk(mv[0], mv[1]); pw[2 * hh + 1] = pk(mv[2], mv[3]); }
            mp[ks] = __builtin_bit_cast(bf16x8, pw); }
        {
            const int row = row0 + l;
            f32x4 y[4];
#pragma unroll
            for (int pt = 0; pt < 4; ++pt) y[pt] = (f32x4){0.f, 0.f, 0.f, 0.f};
#pragma unroll
            for (int ks = 0; ks < 4; ++ks) { const bf16x8 bf = *(LAS bf16x8*)(lds + SP_CM + l * PC + (32 * ks + 8 * kq) * 2);
                const LAS unsigned char* hp = lds + SP_HP + l16 * PC + (32 * ks + 8 * kq) * 2;
#pragma unroll
                for (int pt = 0; pt < 4; ++pt) { const bf16x8 af = *(LAS bf16x8*)(hp + 16 * pt * PC); y[pt] = MFMA16(af, bf, y[pt]); } }
            const float el = fexp(al);
#pragma unroll
            for (int pt = 0; pt < 4; ++pt) y[pt] = y[pt] * el;
            const int nk = (w >> 1) + 1;
#pragma unroll
            for (int ks = 0; ks < 4; ++ks) if (ks < nk) {
                const LAS unsigned char* ap = lds + SP_XS + (32 * ks + 4 * kq + (l16 >> 2)) * PX + (4 * (l16 & 3)) * 2;
#pragma unroll
                for (int pt = 0; pt < 4; ++pt) { const bf16x8 af = cat8(lds_tr(ap + 32 * pt), lds_tr(ap + 32 * pt + 16 * PX)); y[pt] = MFMA16(af, mp[ks], y[pt]); } }
            float ss = 0.f;
#pragma unroll
            for (int pt = 0; pt < 4; ++pt) {
                const u32x2 xv = *(LAS u32x2*)(lds + SP_XS + l * PX + (16 * pt + 4 * kq) * 2);
                const u32x2 zz = zc[pt];
                const float x0 = bflo(xv.x), x1 = bfhi(xv.x), x2 = bflo(xv.y), x3 = bfhi(xv.y);
                const float o0 = (y[pt][0] + dsk * x0) * silu_f(bflo(zz.x)), o1 = (y[pt][1] + dsk * x1) * silu_f(bfhi(zz.x));
                const float o2 = (y[pt][2] + dsk * x2) * silu_f(bflo(zz.y)), o3 = (y[pt][3] + dsk * x3) * silu_f(bfhi(zz.y));
                ss += (o0 * o0 + o1 * o1) + (o2 * o2 + o3 * o3);
                u32x2 o; o.x = pk(o0, o1); o.y = pk(o2, o3);
                *(u32x2*)(YG + (size_t)row * DIN + h * 64 + 16 * pt + 4 * kq) = o;
            }
            ss += __shfl_xor(ss, 16); ss += __shfl_xor(ss, 32);
            if (kq == 0) SSQH[(size_t)row * 32 + h] = ss;
        }
        __syncthreads();
#pragma unroll
        for (int pt = 0; pt < 4; ++pt) { u32x2 o; o.x = pk(hacc[pt][0], hacc[pt][1]); o.y = pk(hacc[pt][2], hacc[pt][3]);
            *(LAS u32x2*)(lds + SP_HP + (16 * pt + l16) * PC + (16 * w + 4 * kq) * 2) = o; }
    }
#undef SSD_LOAD
    float* so = C.out + OUT_SSMP + (size_t)(b * 32 + h) * 8192;
#pragma unroll
    for (int pt = 0; pt < 4; ++pt) *(f32x4*)(so + (size_t)(16 * pt + l16) * 128 + 16 * w + 4 * kq) = hacc[pt];
    __syncthreads();
}
__device__ __forceinline__ void ssd_sample_all(Ctx& C) {
    const int tid = C.tid, lane = C.lane;
    const bf16_t* ACT = (const bf16_t*)(C.ws + WS_ACT); const bf16_t* ZX = (const bf16_t*)(C.ws + WS_ZX); const float* DT = (const float*)(C.ws + WS_DT);
    bf16_t* YG = (bf16_t*)(C.ws + WS_YG); float* SSQH = (float*)(C.ws + WS_SSQH);
    const float* alog_ = INP(17); const float* dtb_ = INP(16); const float* dsk_ = INP(18); const float* stin_ = INP(4);
    const int p = tid >> 3, n0 = (tid & 7) * 16;
    constexpr int ARR = 12544;
    f32x4 hn[4]; unsigned short an[5]; unsigned short zn = 0; float dtn = 0.f;
#define SLOAD(uu) do { const int b_ = (uu) >> 5, h_ = (uu) & 31, g_ = h_ >> 2, m0_ = TP + b_ * 8; const float* sp_ = stin_ + (size_t)(b_ * 32 + h_) * 8192 + p * 128 + n0; \
        _Pragma("unroll") for (int i = 0; i < 4; ++i) hn[i] = __builtin_nontemporal_load((const f32x4*)(sp_ + 4 * i)); \
        an[0] = ACT[(size_t)(m0_ + (tid >> 6)) * CONVD + h_ * 64 + (tid & 63)]; \
        _Pragma("unroll") for (int k = 0; k < 2; ++k) { const int q = tid + 512 * k; an[1 + k] = ACT[(size_t)(m0_ + (q >> 7)) * CONVD + 2048 + g_ * 128 + (q & 127)]; an[3 + k] = ACT[(size_t)(m0_ + (q >> 7)) * CONVD + 3072 + g_ * 128 + (q & 127)]; } \
        zn = ZX[(size_t)(m0_ + (tid >> 6)) * NZX + h_ * 64 + (tid & 63)]; if (tid < 8) dtn = DT[(size_t)(m0_ + tid) * 32 + h_]; } while (0)
    int u = C.bid; if (u >= 4096) return;
    SLOAD(u);
    int par = 0;
#pragma unroll 1
    for (; u < 4096; u += C.G) {
        const int b = u >> 5, h = u & 31, m0 = TP + b * 8;
        const float a = -__expf(alog_[h]), dtb = dtb_[h], dsk = dsk_[h];
        LAS float* xs = (LAS float*)(C.lds + par * ARR); LAS float* Bs = xs + 512; LAS float* Cs = Bs + 1024; LAS float* yv = Cs + 1024; LAS float* dts = yv + 512;
        xs[tid] = __uint_as_float((unsigned)an[0] << 16);
#pragma unroll
        for (int k = 0; k < 2; ++k) { Bs[tid + 512 * k] = __uint_as_float((unsigned)an[1 + k] << 16); Cs[tid + 512 * k] = __uint_as_float((unsigned)an[3 + k] << 16); }
        if (tid < 8) { const float d = softplus_f(dtn + dtb); dts[tid] = d; dts[8 + tid] = __expf(d * a); }
        f32x4 hs[4];
#pragma unroll
        for (int i = 0; i < 4; ++i) hs[i] = hn[i];
        const float z = __uint_as_float((unsigned)zn << 16);
        __syncthreads();
        if (u + C.G < 4096) SLOAD(u + C.G);
#pragma unroll
        for (int t = 0; t < 8; ++t) {
            const float dec = dts[8 + t], dtx = dts[t] * xs[t * 64 + p];
            float yp = 0.f;
#pragma unroll
            for (int i = 0; i < 4; ++i) { const f32x4 bv = *(LAS f32x4*)(Bs + t * 128 + n0 + 4 * i), cv = *(LAS f32x4*)(Cs + t * 128 + n0 + 4 * i);
                hs[i] = hs[i] * dec + bv * dtx; yp += (hs[i][0] * cv[0] + hs[i][1] * cv[1]) + (hs[i][2] * cv[2] + hs[i][3] * cv[3]); }
            yp += __shfl_xor(yp, 1); yp += __shfl_xor(yp, 2); yp += __shfl_xor(yp, 4);
            if ((tid & 7) == 0) yv[t * 64 + p] = yp;
        }
        float* so = C.out + OUT_SSMS + (size_t)(b * 32 + h) * 8192 + p * 128 + n0;
#pragma unroll
        for (int i = 0; i < 4; ++i) __builtin_nontemporal_store(hs[i], (f32x4*)(so + 4 * i));
        __syncthreads();
        {
            const int t = tid >> 6, pp = tid & 63, row = m0 + t;
            const float o = (yv[tid] + dsk * xs[tid]) * silu_f(z);
            YG[(size_t)row * DIN + h * 64 + pp] = (bf16_t)(pk(o, 0.f) & 0xffffu);
            const float ss = wave_sum(o * o);
            if (lane == 0) SSQH[(size_t)row * 32 + h] = ss;
        }
        par ^= 1;
    }
#undef SLOAD
    __syncthreads();
}
__device__ __forceinline__ void p_ssd(Ctx& C) {
    for (int u = C.bid; u < 256; u += C.G) ssd_prompt_unit(C, u >> 5, u & 31);
    ssd_sample_all(C);
}

__device__ __forceinline__ void p_gnorm(Ctx& C) {
    bf16_t* YG = (bf16_t*)(C.ws + WS_YG); const float* SSQH = (const float*)(C.ws + WS_SSQH); const bf16_t* ZX = (const bf16_t*)(C.ws + WS_ZX);
    const int gw = C.bid * NWAVES + C.wave, NGW = C.G * NWAVES, lane = C.lane;
    for (int m0 = gw; m0 < T; m0 += 2 * NGW) {
        u32x4 v[2][4]; f32x4 q[2][4];
#pragma unroll
        for (int rr = 0; rr < 2; ++rr) { const int m = (m0 + rr * NGW < T) ? m0 + rr * NGW : m0; const u32x4* rp = (const u32x4*)(YG + (size_t)m * DIN);
#pragma unroll
            for (int i = 0; i < 4; ++i) { const int c = lane + 64 * i; q[rr][i] = *(const f32x4*)(SSQH + (size_t)m * 32 + 4 * (c >> 5)); v[rr][i] = rp[c]; } }
#pragma unroll
        for (int rr = 0; rr < 2; ++rr) if (rr == 0 || m0 + NGW < T) { const int m = m0 + rr * NGW; u32x4* rp = (u32x4*)(YG + (size_t)m * DIN);
#pragma unroll
            for (int i = 0; i < 4; ++i) { const int c = lane + 64 * i; const f32x4 qq = q[rr][i];
                const float r = rsqrtf(((qq[0] + qq[1]) + (qq[2] + qq[3])) * (1.0f / 256.0f) + EPS);
                u32x4 o = v[rr][i];
#pragma unroll
                for (int k = 0; k < 4; ++k) o[k] = pk(bflo(o[k]) * r, bfhi(o[k]) * r);
                rp[c] = o; } }
    }
    for (int r = C.bid; r < 408; r += C.G) {
        const int sq = r / 3, k = r - 3 * sq;
        const int row = sq < 8 ? sq * 2048 + 2045 + k : TP + (sq - 8) * 8 + 5 + k;
        float* o = sq < 8 ? C.out + OUT_CONVP + (size_t)(sq * 3 + k) * CONVD : C.out + OUT_CONVS + (size_t)((sq - 8) * 3 + k) * CONVD;
        const u32x4 v = *(const u32x4*)(ZX + (size_t)row * NZX + 2048 + C.tid * 8);
        *(f32x4*)(o + C.tid * 8) = (f32x4){bflo(v.x), bfhi(v.x), bflo(v.y), bfhi(v.y)};
        *(f32x4*)(o + C.tid * 8 + 4) = (f32x4){bflo(v.z), bfhi(v.z), bflo(v.w), bfhi(v.w)};
    }
}

constexpr int KP = 544, VP = 544;
__device__ __forceinline__ void stage_kv(LAS unsigned char* lds, const float* G, int pitch, int tid) {
#pragma unroll 1
    for (int it = 0; it < 32; it += 8) {
        f32x4 v[8];
#pragma unroll
        for (int u = 0; u < 8; ++u) { const int idx = (it + u) * 512 + tid; v[u] = __builtin_nontemporal_load((const f32x4*)(G + (size_t)(idx >> 6) * 1024 + (idx & 63) * 4)); }
#pragma unroll
        for (int u = 0; u < 8; ++u) { const int idx = (it + u) * 512 + tid; u32x2 o; o.x = pk(v[u][0], v[u][1]); o.y = pk(v[u][2], v[u][3]);
            *(LAS u32x2*)(lds + (idx >> 6) * pitch + (idx & 63) * 8) = o; }
    }
}
__device__ __forceinline__ void stage_kv_bf(LAS unsigned char* lds, const bf16_t* G, int pitch, int tid) {
#pragma unroll 1
    for (int it = 0; it < 16; it += 8) {
        u32x4 v[8];
#pragma unroll
        for (int u = 0; u < 8; ++u) { const int idx = (it + u) * 512 + tid; v[u] = *(const u32x4*)(G + (size_t)(idx >> 5) * 1024 + (idx & 31) * 8); }
#pragma unroll
        for (int u = 0; u < 8; ++u) { const int idx = (it + u) * 512 + tid; *(LAS u32x4*)(lds + (idx >> 5) * pitch + (idx & 31) * 16) = v[u]; }
    }
}
template <bool PROMPT>
__device__ __forceinline__ void attn_unit(Ctx& C, const void* Kg, const void* Vg, const bf16_t* Qg, bf16_t* Og) {
    constexpr int NRS = PROMPT ? 2 : 1, nrows = PROMPT ? 256 : 8;
    LAS unsigned char* lds = C.lds;
    const int tid = opqv(C.tid), lane = tid & 63, w = C.wave, l16 = lane & 15, kq = lane >> 4;
    const bool active = PROMPT || (w == 0);
    if (PROMPT) stage_kv_bf(lds, (const bf16_t*)Kg, KP, tid); else stage_kv(lds, (const float*)Kg, KP, tid);
    bf16x8 pf[NRS][8]; float inv[NRS];
    __syncthreads();
    if (active) {
#pragma unroll
        for (int rs = 0; rs < NRS; ++rs) {
            int q = rs * 128 + w * 16 + l16; if (q >= nrows) q = nrows - 1;
            const bf16_t* qp = Qg + (size_t)q * 1024 + 8 * kq;
            bf16x8 qf[8];
#pragma unroll
            for (int ks = 0; ks < 8; ++ks) qf[ks] = *(const bf16x8*)(qp + 32 * ks);
            f32x4 st[16];
#pragma unroll
            for (int kt = 0; kt < 16; ++kt) { f32x4 acc = (f32x4){0.f, 0.f, 0.f, 0.f};
                const unsigned ko = (unsigned)((16 * kt + l16) * KP + 16 * kq);
#pragma unroll
                for (int ks = 0; ks < 8; ++ks) { const bf16x8 af = *(LAS bf16x8*)(lds + ko + 64 * ks); acc = MFMA16(af, qf[ks], acc); }
                st[kt] = acc; asm volatile("" ::: "memory"); }
            float mx = -3.0e38f;
#pragma unroll
            for (int kt = 0; kt < 16; ++kt) mx = fmaxf(fmaxf(mx, fmaxf(st[kt][0], st[kt][1])), fmaxf(st[kt][2], st[kt][3]));
            mx = fmaxf(mx, __shfl_xor(mx, 16)); mx = fmaxf(mx, __shfl_xor(mx, 32));
            float sm = 0.f;
#pragma unroll
            for (int kt = 0; kt < 16; ++kt)
#pragma unroll
                for (int j = 0; j < 4; ++j) { const float pv = __builtin_amdgcn_exp2f(st[kt][j] - mx); st[kt][j] = pv; sm += pv; }
            sm += __shfl_xor(sm, 16); sm += __shfl_xor(sm, 32);
            inv[rs] = 1.0f / sm;
#pragma unroll
            for (int kk = 0; kk < 8; ++kk) { u32x4 pw; pw.x = pk(st[2 * kk][0], st[2 * kk][1]); pw.y = pk(st[2 * kk][2], st[2 * kk][3]); pw.z = pk(st[2 * kk + 1][0], st[2 * kk + 1][1]); pw.w = pk(st[2 * kk + 1][2], st[2 * kk + 1][3]);
                pf[rs][kk] = __builtin_bit_cast(bf16x8, pw); }
        }
    }
    __syncthreads();
    if (PROMPT) stage_kv_bf(lds, (const bf16_t*)Vg, VP, tid); else stage_kv(lds, (const float*)Vg, VP, tid);
    __syncthreads();
    if (active) {
#pragma unroll
        for (int rs = 0; rs < NRS; ++rs) {
            const int q = rs * 128 + w * 16 + l16;
#pragma unroll
            for (int dt = 0; dt < 16; ++dt) { f32x4 acc = (f32x4){0.f, 0.f, 0.f, 0.f};
#pragma unroll
                for (int kk = 0; kk < 8; ++kk) { const LAS unsigned char* ap = lds + (unsigned)((32 * kk + 4 * kq + (l16 >> 2)) * VP + (16 * dt + 4 * (l16 & 3)) * 2);
                    const bf16x8 af = cat8(lds_tr(ap), lds_tr(ap + 16 * VP)); acc = MFMA16(af, pf[rs][kk], acc); }
                if (q < nrows) { const float iv = inv[rs]; u32x2 o; o.x = pk(acc[0] * iv, acc[1] * iv); o.y = pk(acc[2] * iv, acc[3] * iv); *(u32x2*)(Og + (size_t)q * 1024 + 16 * dt + 4 * kq) = o; }
                asm volatile("" ::: "memory"); }
        }
    }
    __syncthreads();
}
__device__ __forceinline__ void p_attn(Ctx& C, int layer) {
    const bf16_t* QB = (const bf16_t*)(C.ws + WS_QB); bf16_t* OB = (bf16_t*)(C.ws + WS_OB); const bf16_t* KVB = (const bf16_t*)(C.ws + WS_KVB);
    const int cls = (C.G == 256) ? C.bid % 3 : 0;
    for (int u0 = C.bid, k = 0; u0 < 768; u0 += C.G, ++k) {
        int u = u0; if (C.G == 256) { const int kk = cls == 0 ? k : (cls == 1 ? (k == 0 ? 1 : (k == 1 ? 0 : 2)) : (k + 1) % 3); u = C.bid + 256 * kk; }
        if (u < 256) { const int qt = u & 7, h = (u >> 3) & 3, b = u >> 5;
            const size_t ko = ((size_t)(layer * 2) * 2048 + (size_t)b * 256) * 1024 + h * 256; const size_t qo = (size_t)(b * 2048 + qt * 256) * 1024 + h * 256;
            attn_unit<true>(C, KVB + ko, KVB + ko + (size_t)2048 * 1024, QB + qo, OB + qo);
        } else { const int v = u - 256, h = v & 3, b = v >> 2;
            const size_t kvo = (size_t)layer * 128 * 256 * 1024 + (size_t)b * 256 * 1024 + h * 256; const size_t qo = (size_t)(TP + b * 8) * 1024 + h * 256;
            attn_unit<false>(C, INP(2) + kvo, INP(3) + kvo, QB + qo, OB + qo);
        }
    }
}

constexpr int SG_P = 544, SG_T = 64 * SG_P, SG_RED = 4 * SG_T;
template <int MODE>
__device__ __forceinline__ void sgemm_sample(Ctx& C, const bf16_t* A, int lda, int apn, const bf16_t* Bt, int K, const float* base, float* X, bf16_t* XB, float* ssq, bf16_t* O) {
    LAS unsigned char* lds = C.lds;
    const int ns = K >> 8;
    for (int t = C.bid; t < 256; t += C.G) {
        const int tid = opqv(C.tid), lane = tid & 63, w = C.wave, l16 = lane & 15, kq = lane >> 4, wm = w & 3, wn = w >> 2;
        const int tm = t & 15, tn = t >> 4;
        const bf16_t* Ap = A + (size_t)(TP + 64 * tm) * lda + (tn >> 2) * apn;
        const bf16_t* Bp = Bt + (size_t)(64 * tn) * K;
        u32x4 ra[4], rb[4];
#pragma unroll
        for (int i = 0; i < 4; ++i) { const int id = tid + 512 * i, row = id >> 5, cc = id & 31;
            ra[i] = *(const u32x4*)(Ap + (size_t)row * lda + cc * 8); rb[i] = *(const u32x4*)(Bp + (size_t)row * K + cc * 8); }
        __syncthreads();
#pragma unroll
        for (int i = 0; i < 4; ++i) { const int id = tid + 512 * i, row = id >> 5, cc = id & 31;
            *(LAS u32x4*)(lds + row * SG_P + cc * 16) = ra[i]; *(LAS u32x4*)(lds + SG_T + row * SG_P + cc * 16) = rb[i]; }
        __syncthreads();
        f32x4 acc[2] = {(f32x4){0.f, 0.f, 0.f, 0.f}, (f32x4){0.f, 0.f, 0.f, 0.f}};
#pragma unroll 1
        for (int st = 0; st < ns; ++st) {
            const int buf = st & 1;
            if (st + 1 < ns) {
#pragma unroll
                for (int i = 0; i < 4; ++i) { const int id = tid + 512 * i, row = id >> 5, cc = id & 31;
                    ra[i] = *(const u32x4*)(Ap + (size_t)row * lda + (st + 1) * 256 + cc * 8); rb[i] = *(const u32x4*)(Bp + (size_t)row * K + (st + 1) * 256 + cc * 8); }
            }
            const LAS unsigned char* ab = lds + buf * 2 * SG_T + (16 * wm + l16) * SG_P + kq * 16;
            const LAS unsigned char* bb = lds + buf * 2 * SG_T + SG_T + (32 * wn + l16) * SG_P + kq * 16;
#pragma unroll
            for (int ks = 0; ks < 8; ++ks) { const bf16x8 af = *(LAS bf16x8*)(ab + ks * 64);
                const bf16x8 b0 = *(LAS bf16x8*)(bb + ks * 64), b1 = *(LAS bf16x8*)(bb + 16 * SG_P + ks * 64);
                acc[0] = MFMA16(b0, af, acc[0]); acc[1] = MFMA16(b1, af, acc[1]); }
            if (st + 1 < ns) {
#pragma unroll
                for (int i = 0; i < 4; ++i) { const int id = tid + 512 * i, row = id >> 5, cc = id & 31;
                    *(LAS u32x4*)(lds + (buf ^ 1) * 2 * SG_T + row * SG_P + cc * 16) = ra[i]; *(LAS u32x4*)(lds + (buf ^ 1) * 2 * SG_T + SG_T + row * SG_P + cc * 16) = rb[i]; }
            }
            __syncthreads();
        }
        const int row = TP + 64 * tm + 16 * wm + l16, col0 = 64 * tn + 32 * wn + 4 * kq;
        if (MODE == 0) {
            float sq = 0.f;
#pragma unroll
            for (int j = 0; j < 2; ++j) { const size_t off = (size_t)row * 1024 + col0 + 16 * j;
                const f32x4 x = *(const f32x4*)(base + off) + acc[j];
                sq += (x[0] * x[0] + x[1] * x[1]) + (x[2] * x[2] + x[3] * x[3]);
                *(f32x4*)(X + off) = x; if (XB) { u32x2 o; o.x = pk(x[0], x[1]); o.y = pk(x[2], x[3]); *(u32x2*)(XB + off) = o; } }
            sq += __shfl_xor(sq, 16); sq += __shfl_xor(sq, 32);
            LAS float* red = (LAS float*)(lds + SG_RED);
            if (wn == 1 && kq == 0) red[16 * wm + l16] = sq;
            __syncthreads();
            if (wn == 0 && kq == 0) ssq[(size_t)row * 16 + tn] = sq + red[16 * wm + l16];
        } else {
            const float r = row_rstd(ssq, row);
#pragma unroll
            for (int j = 0; j < 2; ++j) { const f32x4 v = acc[j] * r; u32x2 o; o.x = pk(v[0], v[1]); o.y = pk(v[2], v[3]); *(u32x2*)(O + (size_t)row * 1024 + col0 + 16 * j) = o; }
        }
    }
    __syncthreads();
}

template <int W> __device__ __forceinline__ void pool_run(Ctx& C, bool sample, int b, int t0, int nrows, LAS const float* rs) {
    const int c0 = C.tid * 2;
    const float* X = C.out + OUT_X; bf16_t* PO = (bf16_t*)(C.ws + WS_OB);
    const f32x2 gm = *(const f32x2*)(INP(8) + 1024 + c0); const float* spool_ = INP(6);
    const int mbase = sample ? TP + b * 8 : b * 2048 + t0;
    f32x2 ring[16]; f32x2 S = (f32x2){0.f, 0.f};
#pragma unroll
    for (int k = 0; k < 16; ++k) ring[k] = (f32x2){0.f, 0.f};
    const int nblk = (nrows + 16 + 15) / 16;
    for (int blk = 0; blk < nblk; ++blk) {
#pragma unroll
        for (int k = 0; k < 16; ++k) {
            const int r = blk * 16 + k - 16;
            if (r < nrows) {
                f32x2 u = (f32x2){0.f, 0.f};
                if (r >= 0) { const f32x2 xv = *(const f32x2*)(X + (size_t)(mbase + r) * 1024 + c0); const float rr = rs[r + 16]; u = xv * rr * gm; }
                else if (sample) { if (r >= -15) u = *(const f32x2*)(spool_ + (size_t)(b * 15 + r + 15) * 1024 + c0); }
                else if (t0 > 0 && r >= -15) { const f32x2 xv = *(const f32x2*)(X + (size_t)(mbase + r) * 1024 + c0); const float rr = rs[r + 16]; u = xv * rr * gm; }
                S = S + u - ring[(k + 16 - W) & 15];
                ring[k] = u;
                if (r >= 0) {
                    const int pos = sample ? TP + r : t0 + r;
                    const float cnt = (float)((pos + 1) < W ? (pos + 1) : W);
                    const f32x2 pl = S * (1.0f / cnt) - u;
                    *(unsigned*)(PO + (size_t)(mbase + r) * 1024 + c0) = pk(pl[0], pl[1]);
                    if (sample) *(f32x2*)(C.out + OUT_POOLS + (size_t)(b * 15 + 7 + r) * 1024 + c0) = u;
                    else if (t0 + r >= 2033) *(f32x2*)(C.out + OUT_POOLP + (size_t)(b * 15 + (t0 + r - 2033)) * 1024 + c0) = u;
                }
            }
        }
    }
}
__device__ __forceinline__ void p_pool_elem(Ctx& C) {
    LAS float* rs = (LAS float*)C.lds;
    const float* ssq = (const float*)(C.ws + WS_SSQ);
    for (int u = C.bid; u < 256 + 128; u += C.G) {
        const bool sample = u >= 256;
        const int b = sample ? u - 256 : u >> 5, t0 = sample ? 0 : (u & 31) * 64, nrows = sample ? 8 : 64;
        const int mbase = sample ? TP + b * 8 : b * 2048 + t0;
        __syncthreads();
        if (C.tid < 80) { const int r = C.tid - 16; float v = 0.f; if (r < nrows && (r >= 0 || (!sample && t0 > 0))) v = row_rstd(ssq, mbase + r); rs[C.tid] = v; }
        __syncthreads();
        const int grp = C.tid >> 7;
        if (grp == 0) pool_run<2>(C, sample, b, t0, nrows, rs); else if (grp == 1) pool_run<4>(C, sample, b, t0, nrows, rs);
        else if (grp == 2) pool_run<8>(C, sample, b, t0, nrows, rs); else pool_run<16>(C, sample, b, t0, nrows, rs);
        if (sample) {
            const float* spool_ = INP(6);
            for (int i = C.tid; i < 7 * 256; i += NTHR) { const int j = i >> 8, c4 = (i & 255) * 4;
                *(f32x4*)(C.out + OUT_POOLS + (size_t)(b * 15 + j) * 1024 + c4) = *(const f32x4*)(spool_ + (size_t)(b * 15 + 8 + j) * 1024 + c4); }
        }
    }
}

__device__ __forceinline__ void p_final(Ctx& C) {
    float* X = C.out + OUT_X; const float* ssq = (const float*)(C.ws + WS_SSQ); const float* gf = INP(12);
    const int gw = C.bid * NWAVES + C.wave, NGW = C.G * NWAVES;
    const f32x4* gp = (const f32x4*)gf + C.lane;
    f32x4 gv[4];
#pragma unroll
    for (int j = 0; j < 4; ++j) gv[j] = gp[64 * j];
    for (int m0 = gw; m0 < T; m0 += 2 * NGW) {
        const int m1 = (m0 + NGW < T) ? m0 + NGW : m0;
        f32x4* x0 = (f32x4*)(X + (size_t)m0 * 1024) + C.lane; f32x4* x1 = (f32x4*)(X + (size_t)m1 * 1024) + C.lane;
        f32x4 a[4], b[4];
#pragma unroll
        for (int j = 0; j < 4; ++j) { a[j] = x0[64 * j]; b[j] = x1[64 * j]; }
        const float r0 = row_rstd(ssq, m0), r1 = row_rstd(ssq, m1);
#pragma unroll
        for (int j = 0; j < 4; ++j) x0[64 * j] = a[j] * r0 * gv[j];
        if (m1 != m0) {
#pragma unroll
            for (int j = 0; j < 4; ++j) x1[64 * j] = b[j] * r1 * gv[j];
        }
    }
}

constexpr int N_PHASES = 19;
#ifndef MK_MULTI
#define MK_MULTI 0
#endif
typedef pg8::StaticOrder SO;
__global__ void __launch_bounds__(NTHR, 2) fwd_kernel(Args args) {
    extern __shared__ __attribute__((aligned(16))) unsigned char lds_raw[];
    Ctx C; C.lds = (LAS unsigned char*)lds_raw; C.ws = args.ws; C.out = args.out;
    C.tid = threadIdx.x; C.lane = C.tid & 63; C.wave = __builtin_amdgcn_readfirstlane(C.tid >> 6); C.G = gridDim.x; C.bid = blockIdx.x;
    volatile LAS unsigned* MISC = (volatile LAS unsigned*)(C.lds + MISC_OFF);
    if (C.tid < 16) MISC[C.tid] = 0u;
    __syncthreads();
    const int lo = args.ph_lo, hi = args.ph_hi;
    XcdBarrier bar; bar.bar = (unsigned*)(C.ws + WS_CTL) + CW_BAR; bar.x = 0; bar.st = MISC;
    if (hi - lo > 1) bar = xcd_barrier_post((unsigned*)(C.ws + WS_CTL) + CW_BAR, MISC);
#ifndef PH_MASK
#define PH_MASK 0x7ffff
#endif
#define IN(k) (((PH_MASK >> (k)) & 1) && lo <= (k) && (k) < hi)
#ifndef REP_PHASE
#define REP_PHASE -1
#endif
#define REPN(k) for (int rep_ = 0; rep_ < ((k) == REP_PHASE ? 2 : 1); ++rep_)
#define SEAM(k) do { if (IN(k) && IN((k) + 1)) xcd_barrier(bar); } while (0)
    LAS unsigned char* ring = C.lds;
#define PHP unsigned char* ws = opqs(args.ws); float* OUTP = opqs(args.out); bf16_t* XB = (bf16_t*)(ws + WS_XB); float* SSQ = (float*)(ws + WS_SSQ); float* X = OUTP + OUT_X; (void)XB; (void)SSQ; (void)X;

    if (IN(0)) REPN(0) { p_prologue(C); } SEAM(0);
    if (IN(1)) REPN(1) {
        PHP
        pg8::Gemm g{XB, (const bf16_t*)(ws + WS_WIN), T, NINP, 1024, 1024, 0}; SO S; S.init(T, NINP, C.G, C.bid);
        fill_rstd_table(ring, S, SSQ);
        EpiInProj E{(bf16_t*)(ws + WS_ZX), (float*)(ws + WS_DT), (LAS const float*)(ring + RSTD_TAB_OFF), 0};
        pg8::gemm_phase<EpiInProj, SO, true, true>(ring, g, S, E);
        {
            pg8::Gemm g2{(const bf16_t*)(ws + WS_MEMB), (const bf16_t*)(ws + WS_WKV), 2048, 2048, 1024, 1024, 0}; SO S2; S2.init(2048, 2048, C.G, (C.bid + C.G - 192) % C.G);
            EpiMemKV E2{OUTP + OUT_MK, (const float*)(ws + WS_MEMR), 0, (bf16_t*)(ws + WS_KVB)};
            pg8::gemm_phase<EpiMemKV, SO, true, true>(ring, g2, S2, E2);
        }
        if (C.G == 256 && C.bid >= 164 && C.bid < 192) convert_weights<2>(C, (C.bid - 164) * NWAVES + C.wave, 28 * NWAVES);
        else if (C.G != 256) convert_weights<2>(C, C.bid * NWAVES + C.wave, C.G * NWAVES);
    } SEAM(1);
    if (IN(2)) REPN(2) { p_conv(C); } SEAM(2);
    if (IN(3)) REPN(3) { p_ssd(C); } SEAM(3);
    if (IN(4)) { p_gnorm(C); } SEAM(4);
    if (IN(5)) {
        PHP
        pg8::Gemm g{(const bf16_t*)(ws + WS_YG), (const bf16_t*)(ws + WS_WOUT), TP, 1024, 2048, 2048, 0}; SO S; S.init(TP, 1024, C.G, C.bid);
        const float* xs_ = INP(1) - (size_t)TP * 1024;
        EpiResid E{INP(0), xs_, X, XB, SSQ};
        pg8::gemm_phase<EpiResid, SO, true, true>(ring, g, S, E);
        sgemm_sample<0>(C, g.A, 2048, 0, g.Bt, 2048, xs_, X, XB, SSQ, nullptr);
    } SEAM(5);
#pragma unroll 1
    for (int ly = 0; ly < 2; ++ly) {
        const int pb = ly == 0 ? 6 : 13;
        if (ly == 1) {
            if (IN(11)) { p_pool_elem(C); } SEAM(11);
            if (IN(12)) {
                PHP
                pg8::Gemm g{(const bf16_t*)(ws + WS_OB), (const bf16_t*)(ws + WS_WPOOL), TP, 1024, 256, 1024, 256}; SO S; S.init(TP, 1024, C.G, C.bid);
                EpiResid E{X, X, X, XB, SSQ};
                pg8::gemm_phase<EpiResid, SO, true, true>(ring, g, S, E);
                sgemm_sample<0>(C, g.A, 1024, 256, g.Bt, 256, X, X, XB, SSQ, nullptr);
            } SEAM(12);
        }
        if (IN(pb)) {
            PHP
            pg8::Gemm g{XB, (const bf16_t*)(ws + WS_WQ) + (size_t)ly * 1048576, TP, 1024, 1024, 1024, 0}; SO S; S.init(TP, 1024, C.G, C.bid);
            fill_rstd_table(ring, S, SSQ);
            EpiScaleBf16<0> E{(bf16_t*)(ws + WS_QB), 1024, (LAS const float*)(ring + RSTD_TAB_OFF), 0};
            pg8::gemm_phase<EpiScaleBf16<0>, SO, true, true>(ring, g, S, E);
            sgemm_sample<1>(C, g.A, 1024, 0, g.Bt, 1024, nullptr, nullptr, nullptr, SSQ, (bf16_t*)(ws + WS_QB));
        } SEAM(pb);
        if (IN(pb + 1)) REPN(pb + 1) { p_attn(C, ly); } SEAM(pb + 1);
        if (IN(pb + 2)) {
            PHP
            pg8::Gemm g{(const bf16_t*)(ws + WS_OB), (const bf16_t*)(ws + WS_WO) + (size_t)ly * 1048576, TP, 1024, 1024, 1024, 0}; SO S; S.init(TP, 1024, C.G, C.bid);
            EpiResid E{X, X, X, XB, SSQ};
            pg8::gemm_phase<EpiResid, SO, true, true>(ring, g, S, E);
            sgemm_sample<0>(C, g.A, 1024, 0, g.Bt, 1024, X, X, XB, SSQ, nullptr);
        } SEAM(pb + 2);
        if (IN(pb + 3)) REPN(pb + 3) {
            PHP
            pg8::Gemm g{XB, (const bf16_t*)(ws + WS_WUP) + (size_t)ly * 4194304, T, 4096, 1024, 1024, 0}; SO S; S.init(T, 4096, C.G, C.bid);
            fill_rstd_table(ring, S, SSQ);
            EpiScaleBf16<1> E{(bf16_t*)(ws + WS_HB), 4096, (LAS const float*)(ring + RSTD_TAB_OFF), 0};
            pg8::gemm_phase<EpiScaleBf16<1>, SO, true, true>(ring, g, S, E);
            if (ly == 0) {
                pg8::Gemm g2{(const bf16_t*)(ws + WS_MEMB), (const bf16_t*)(ws + WS_WKV) + (size_t)2048 * 1024, 2048, 2048, 1024, 1024, 0}; SO S2; S2.init(2048, 2048, C.G, (C.bid + C.G - 64) % C.G);
                EpiMemKV E2{OUTP + OUT_MK, (const float*)(ws + WS_MEMR), 1, (bf16_t*)(ws + WS_KVB)};
                pg8::gemm_phase<EpiMemKV, SO, true, true>(ring, g2, S2, E2);
                const int half = C.G / 2;
                if (C.bid >= half) convert_weights<1>(C, (C.bid - half) * NWAVES + C.wave, (C.G - half) * NWAVES);
            }
        } SEAM(pb + 3);
        if (IN(pb + 4)) {
            PHP
            pg8::Gemm g{(const bf16_t*)(ws + WS_HB), (const bf16_t*)(ws + WS_WDN) + (size_t)ly * 4194304, TP, 1024, 4096, 4096, 0}; SO S; S.init(TP, 1024, C.G, C.bid);
            bf16_t* XBo = (ly == 0) ? XB : (bf16_t*)nullptr;
            EpiResid E{X, X, X, XBo, SSQ};
            pg8::gemm_phase<EpiResid, SO, true, true>(ring, g, S, E);
            sgemm_sample<0>(C, g.A, 4096, 0, g.Bt, 4096, X, X, XBo, SSQ, nullptr);
        } SEAM(pb + 4);
    }
    if (IN(18)) { p_final(C); }
#undef IN
#undef SEAM
}

extern "C" void kernel_launch(void* const* d_in, const int* in_sizes, int n_in, void* d_out, int out_size, void* d_ws, size_t ws_size, hipStream_t stream) {
    static int grid = 0;
    if (grid == 0) {
        if (n_in != 29 || out_size != (int)OUT_TOTAL || ws_size < WS_END) { fprintf(stderr, "kernel_launch: unexpected shapes: n_in %d out %d ws %zu\n", n_in, out_size, ws_size); grid = -1; return; }
        int dev = 0, cus = 0, per_cu = 0;
        if (hipGetDevice(&dev) != hipSuccess || hipDeviceGetAttribute(&cus, hipDeviceAttributeMultiprocessorCount, dev) != hipSuccess) { grid = -1; return; }
        if (hipFuncSetAttribute((const void*)fwd_kernel, hipFuncAttributeMaxDynamicSharedMemorySize, LDS_BYTES) != hipSuccess) { fprintf(stderr, "kernel_launch: hipFuncSetAttribute failed\n"); grid = -1; return; }
        if (hipOccupancyMaxActiveBlocksPerMultiprocessor(&per_cu, (const void*)fwd_kernel, NTHR, LDS_BYTES) != hipSuccess || per_cu < 1) { fprintf(stderr, "kernel_launch: occupancy query says %d\n", per_cu); }
        (void)hipGetLastError();
        grid = cus;
    }
    if (grid < 0) return;
    (void)hipMemsetAsync((char*)d_ws + WS_CTL, 0, CTL_ZERO_BYTES, stream);
    Args a{};
    for (int i = 0; i < 29; ++i) a.in[i] = (const float*)d_in[i];
    a.out = (float*)d_out; a.ws = (unsigned char*)d_ws;
#if MK_MULTI
    for (int p = 0; p < N_PHASES; ++p) { a.ph_lo = p; a.ph_hi = p + 1; hipLaunchKernelGGL(fwd_kernel, dim3(grid), dim3(NTHR), LDS_BYTES, stream, a); }
#else
    a.ph_lo = 0; a.ph_hi = N_PHASES;
    hipLaunchKernelGGL(fwd_kernel, dim3(grid), dim3(NTHR), LDS_BYTES, stream, a);
#endif
}
```

```cpp
#include <hip/hip_runtime.h>
#include <cstdio>
#include <cstdint>
__device__ __forceinline__ int opqv(int v) { asm volatile("" : "+v"(v)); return v; }
template <class P> __device__ __forceinline__ P* opqs(P* p) { asm volatile("" : "+s"(p)); return p; }
namespace pg8 {
#define PG8_LAS __attribute__((address_space(3)))
typedef unsigned short bf16_t;
typedef short bf16x8 __attribute__((ext_vector_type(8)));
typedef float f32x4 __attribute__((ext_vector_type(4)));
typedef unsigned u32x4 __attribute__((ext_vector_type(4)));
constexpr int BM = 256, BK = 64, HALF = 128, HTB = HALF * BK * 2  , STAGE_BYTES = 8 * HTB, NXCD = 8, WGM = 8;

__host__ __device__ __forceinline__ int lds_byte(int r, int c) { const int st = (r >> 4) * 2 + (c >> 5), rr = r & 15, cc = c & 31, ob = rr * 64 + cc * 2; return st * 1024 + (ob ^ (((ob >> 9) & 1) << 5)); }
__host__ __device__ __forceinline__ void stage_rc(int b, int& R, int& C) { const int st = b / 1024, sb = b % 1024, swz = sb ^ (((sb >> 9) & 1) << 5); R = (st >> 1) * 16 + swz / 64; C = (st & 1) * 32 + (swz % 64) / 2; }
__host__ __device__ __forceinline__ int perm32(int rho) { const int n = rho >> 4, i = rho & 15; return 8 * (i >> 2) + 4 * n + (i & 3); }

struct Unit { int pm, pn; };
struct Gemm { const bf16_t* A; const bf16_t* Bt; int M, N, K, lda, apn; };

struct StaticOrder {
    int nM, nN, nwg, G, c;
    __host__ __device__ void init(int M, int N, int G_, int c_) { nM = M / BM; nN = N / BM; nwg = nM * nN; G = G_; c = c_; }
    __host__ __device__ bool next(int i, Unit& u) const {
        const long L = (long)i * G + c; if (L >= nwg) return false;
        int wgid = (int)L; { const int q = nwg / NXCD, r = nwg % NXCD, xcd = wgid % NXCD, off = wgid / NXCD; wgid = (xcd < r ? xcd * (q + 1) : r * (q + 1) + (xcd - r) * q) + off; }
        const int nig = WGM * nN, gid = wgid / nig, fm = gid * WGM, gsz = (nM - fm) < WGM ? (nM - fm) : WGM;
        u.pm = fm + ((wgid % nig) % gsz); u.pn = (wgid % nig) / gsz; return true;
    }
    __device__ __forceinline__ void a_ready(const Unit&) const {}
    __device__ __forceinline__ void done(const Unit&) const {}
};

template <class Epi, class Sched, bool ALIGN_EPI = false, bool SP2 = false>
__device__ __forceinline__ void gemm_phase(PG8_LAS unsigned char* lds, const Gemm g, const Sched& S, const Epi& E) {
    const int tid = opqv((int)threadIdx.x), wid = __builtin_amdgcn_readfirstlane(tid >> 6), lane = tid & 63, wr = wid >> 2, wc = wid & 3, fr = lane & 15, fq = lane >> 4;
    const int K = g.K, nt = K / BK;
    unsigned voffA[2], voffB[2];
#pragma unroll
    for (int i = 0; i < 2; ++i) { int R, C; stage_rc(tid * 16 + i * 8192, R, C); const int Rb = Epi::PERM ? ((R & ~31) + perm32(R & 31)) : R;
        voffA[i] = (unsigned)(R * g.lda + C) * 2u; voffB[i] = (unsigned)(Rb * K + C) * 2u; }
    const size_t kstep = (size_t)(BK * 2);
    const size_t hstepA = (size_t)HALF * g.lda * 2, hstepB = (size_t)HALF * K * 2;
    const size_t tstepA = 2 * hstepA, tstepB = 2 * hstepB, apnb = (size_t)g.apn * 2;
    const unsigned ldsw = (unsigned)wid * 1024u;
    const int aoff = lds_byte(wr * 64 + fr, fq * 8), boff = lds_byte(wc * 32 + fr, fq * 8);
#define PG8_SA(b, h) (((b) * 2 + (h)) * HTB)
#define PG8_SB(b, h) ((4 + (b) * 2 + (h)) * HTB)
#define PG8_STAGE(bufoff, gbase, voff) do { _Pragma("unroll") for (int _i = 0; _i < 2; ++_i) \
        __builtin_amdgcn_global_load_lds((const unsigned*)((const char*)(gbase) + (voff)[_i]), (PG8_LAS unsigned*)(lds + (bufoff) + ldsw + _i * 8192), 16, 0, 0); } while (0)
#define PG8_LDA(dst, b, h) do { _Pragma("unroll") for (int m = 0; m < 4; ++m) _Pragma("unroll") for (int k = 0; k < 2; ++k) dst[m][k] = *(const PG8_LAS bf16x8*)(lds + PG8_SA(b, h) + aoff + m * 2048 + k * 1024); } while (0)
#define PG8_LDB(dst, b, h) do { _Pragma("unroll") for (int n = 0; n < 2; ++n) _Pragma("unroll") for (int k = 0; k < 2; ++k) dst[n][k] = *(const PG8_LAS bf16x8*)(lds + PG8_SB(b, h) + boff + n * 2048 + k * 1024); } while (0)
#define PG8_MMA(ai, bj, At, Bt) do { __builtin_amdgcn_s_setprio(1); _Pragma("unroll") for (int m = 0; m < 4; ++m) _Pragma("unroll") for (int n = 0; n < 2; ++n) _Pragma("unroll") for (int k = 0; k < 2; ++k) \
        acc[ai][bj][m][n] = __builtin_amdgcn_mfma_f32_16x16x32_bf16(Bt[n][k], At[m][k], acc[ai][bj][m][n], 0, 0, 0); __builtin_amdgcn_s_setprio(0); } while (0)
#define PG8_WAIT_V(n) asm volatile("s_waitcnt vmcnt(" #n ")" ::: "memory")
#define PG8_WAIT_L(n) asm volatile("s_waitcnt lgkmcnt(" #n ")" ::: "memory")
#define PG8_BAR __builtin_amdgcn_s_barrier()
#define PG8_SCHED __builtin_amdgcn_sched_barrier(0)
    Unit cur, nxt; int ui = 0;
    if (!S.next(0, cur)) return;
    f32x4 acc[2][2][4][2];
#pragma unroll
    for (int a = 0; a < 2; ++a)
#pragma unroll
        for (int b = 0; b < 2; ++b)
#pragma unroll
            for (int m = 0; m < 4; ++m)
#pragma unroll
                for (int n = 0; n < 2; ++n) acc[a][b][m][n] = (f32x4){0.f, 0.f, 0.f, 0.f};
    bf16x8 At[4][2], B0[2][2], B1[2][2];
    const char* cA = (const char*)g.A + (size_t)cur.pm * tstepA + (size_t)cur.pn * apnb; const char* cB = (const char*)g.Bt + (size_t)cur.pn * tstepB;
    S.a_ready(cur);
    if constexpr (SP2) {
        PG8_STAGE(PG8_SB(0, 0), cB, voffB); PG8_STAGE(PG8_SB(0, 1), cB + hstepB, voffB); PG8_STAGE(PG8_SA(0, 0), cA, voffA); PG8_STAGE(PG8_SA(0, 1), cA + hstepA, voffA);
        if (wr == 1) PG8_BAR;
        PG8_WAIT_V(2); PG8_BAR;
        PG8_STAGE(PG8_SB(1, 0), cB + kstep, voffB); PG8_STAGE(PG8_SA(1, 0), cA + kstep, voffA); PG8_STAGE(PG8_SB(1, 1), cB + hstepB + kstep, voffB);
        PG8_WAIT_V(6); PG8_BAR;
    } else {
        PG8_STAGE(PG8_SB(0, 0), cB, voffB); PG8_STAGE(PG8_SA(0, 0), cA, voffA); PG8_STAGE(PG8_SB(0, 1), cB + hstepB, voffB); PG8_STAGE(PG8_SA(0, 1), cA + hstepA, voffA);
        if (wr == 1) PG8_BAR;
        PG8_WAIT_V(4); PG8_BAR;
        PG8_STAGE(PG8_SB(1, 0), cB + kstep, voffB); PG8_STAGE(PG8_SA(1, 0), cA + kstep, voffA); PG8_STAGE(PG8_SB(1, 1), cB + hstepB + kstep, voffB);
        PG8_WAIT_V(6); PG8_BAR;
    }
    for (;;) {
        const bool has_next = S.next(ui + 1, nxt);
        const char* nA = has_next ? (const char*)g.A + (size_t)nxt.pm * tstepA + (size_t)nxt.pn * apnb : cA; const char* nB = has_next ? (const char*)g.Bt + (size_t)nxt.pn * tstepB : cB;
        for (int t = 0; t < nt; t += 2) {
            const bool last = (t == nt - 2);
            const char* a1 = cA + (size_t)(t + 1) * kstep;
            const char* a2 = last ? nA : cA + (size_t)(t + 2) * kstep; const char* b2 = last ? nB : cB + (size_t)(t + 2) * kstep;
            const char* a3 = a2 + kstep; const char* b3 = b2 + kstep;
            if (last && has_next) S.a_ready(nxt);
            if constexpr (SP2) {
            PG8_LDB(B0, 0, 0); PG8_LDB(B1, 0, 1); PG8_SCHED; PG8_LDA(At, 0, 0); PG8_STAGE(PG8_SA(1, 1), a1 + hstepA, voffA);
            PG8_WAIT_V(8); PG8_WAIT_L(0); PG8_BAR; PG8_MMA(0, 0, At, B0); PG8_MMA(0, 1, At, B1); PG8_BAR; PG8_SCHED;
            PG8_LDA(At, 0, 1); PG8_STAGE(PG8_SB(0, 0), b2, voffB); PG8_STAGE(PG8_SB(0, 1), b2 + hstepB, voffB); PG8_STAGE(PG8_SA(0, 0), a2, voffA);
            PG8_WAIT_V(8); PG8_WAIT_L(0); PG8_BAR; PG8_MMA(1, 0, At, B0); PG8_MMA(1, 1, At, B1); PG8_BAR; PG8_SCHED;
            PG8_LDB(B0, 1, 0); PG8_LDB(B1, 1, 1); PG8_SCHED; PG8_LDA(At, 1, 0); PG8_STAGE(PG8_SA(0, 1), a2 + hstepA, voffA);
            PG8_WAIT_V(8); PG8_WAIT_L(0); PG8_BAR; PG8_MMA(0, 0, At, B0); PG8_MMA(0, 1, At, B1); PG8_BAR; PG8_SCHED;
            PG8_LDA(At, 1, 1); PG8_STAGE(PG8_SB(1, 0), b3, voffB); PG8_STAGE(PG8_SB(1, 1), b3 + hstepB, voffB); PG8_STAGE(PG8_SA(1, 0), a3, voffA);
            PG8_WAIT_V(8); PG8_WAIT_L(0); PG8_BAR; PG8_MMA(1, 0, At, B0); PG8_MMA(1, 1, At, B1); PG8_BAR; PG8_SCHED;
            } else {
            PG8_LDB(B0, 0, 0); PG8_SCHED; PG8_LDA(At, 0, 0); PG8_STAGE(PG8_SA(1, 1), a1 + hstepA, voffA);
            PG8_WAIT_L(8); PG8_BAR; PG8_WAIT_L(0); PG8_MMA(0, 0, At, B0); PG8_BAR; PG8_SCHED;
            PG8_LDB(B1, 0, 1); PG8_STAGE(PG8_SB(0, 0), b2, voffB);
            PG8_BAR; PG8_WAIT_L(0); PG8_MMA(0, 1, At, B1); PG8_BAR;
            PG8_LDA(At, 0, 1); PG8_STAGE(PG8_SA(0, 0), a2, voffA);
            PG8_BAR; PG8_WAIT_L(0); PG8_MMA(1, 0, At, B0); PG8_BAR; PG8_SCHED;
            PG8_STAGE(PG8_SB(0, 1), b2 + hstepB, voffB);
            PG8_WAIT_V(6); PG8_BAR; PG8_MMA(1, 1, At, B1); PG8_BAR;
            PG8_LDB(B0, 1, 0); PG8_SCHED; PG8_LDA(At, 1, 0); PG8_STAGE(PG8_SA(0, 1), a2 + hstepA, voffA);
            PG8_WAIT_L(8); PG8_BAR; PG8_WAIT_L(0); PG8_MMA(0, 0, At, B0); PG8_BAR; PG8_SCHED;
            PG8_LDB(B1, 1, 1); PG8_STAGE(PG8_SB(1, 0), b3, voffB);
            PG8_BAR; PG8_WAIT_L(0); PG8_MMA(0, 1, At, B1); PG8_BAR;
            PG8_LDA(At, 1, 1); PG8_STAGE(PG8_SA(1, 0), a3, voffA);
            PG8_BAR; PG8_WAIT_L(0); PG8_MMA(1, 0, At, B0); PG8_BAR; PG8_SCHED;
            PG8_STAGE(PG8_SB(1, 1), b3 + hstepB, voffB);
            PG8_WAIT_V(6); PG8_BAR; PG8_MMA(1, 1, At, B1); PG8_BAR;
            }
        }
        if constexpr (ALIGN_EPI) { if (wr == 0) PG8_BAR; }
        if constexpr (!Epi::AFTER_DRAIN) { E(acc, cur, wr, wc, fr, fq); S.done(cur); }
        if (!has_next) break;
#pragma unroll
        for (int a = 0; a < 2; ++a)
#pragma unroll
            for (int b = 0; b < 2; ++b)
#pragma unroll
                for (int m = 0; m < 4; ++m)
#pragma unroll
                    for (int n = 0; n < 2; ++n) acc[a][b][m][n] = (f32x4){0.f, 0.f, 0.f, 0.f};
        cur = nxt; cA = nA; cB = nB; ++ui;
        if constexpr (ALIGN_EPI) { if (wr == 1) PG8_BAR; }
    }
    PG8_WAIT_V(0);
    if constexpr (!ALIGN_EPI) { if (wr == 0) PG8_BAR; }
    PG8_BAR;
    if constexpr (Epi::AFTER_DRAIN) { E.fused(acc, cur, wr, wc, fr, fq, lds, wid, lane); S.done(cur); }
#undef PG8_SA
#undef PG8_SB
#undef PG8_STAGE
#undef PG8_LDA
#undef PG8_LDB
#undef PG8_MMA
#undef PG8_WAIT_V
#undef PG8_WAIT_L
#undef PG8_BAR
#undef PG8_SCHED
}
}

#define LAS __attribute__((address_space(3)))
using pg8::bf16_t; using pg8::bf16x8; using pg8::f32x4; using pg8::u32x4; using pg8::Unit;
typedef unsigned u32x2 __attribute__((ext_vector_type(2)));
typedef float f32x2 __attribute__((ext_vector_type(2)));
typedef short s16x4 __attribute__((ext_vector_type(4)));
typedef short v4i16_t __attribute__((ext_vector_type(4)));

__device__ __forceinline__ unsigned pk(float lo, float hi) { unsigned r; asm("v_cvt_pk_bf16_f32 %0, %1, %2" : "=v"(r) : "v"(lo), "v"(hi)); return r; }
__device__ __forceinline__ float bflo(unsigned u) { return __uint_as_float(u << 16); }
__device__ __forceinline__ float bfhi(unsigned u) { return __uint_as_float(u & 0xffff0000u); }
__device__ __forceinline__ float fexp(float x) { return __builtin_amdgcn_exp2f(x * 1.4426950408889634f); }
__device__ __forceinline__ float silu_f(float v) { return v * __builtin_amdgcn_rcpf(1.0f + fexp(-v)); }
__device__ __forceinline__ float softplus_f(float v) { return v > 20.f ? v : log1pf(__expf(v)); }
__device__ __forceinline__ s16x4 lds_tr(LAS const unsigned char* p) { return __builtin_bit_cast(s16x4, __builtin_amdgcn_ds_read_tr16_b64_v4i16((LAS v4i16_t*)p)); }
__device__ __forceinline__ bf16x8 cat8(s16x4 lo, s16x4 hi) { return (bf16x8){lo[0], lo[1], lo[2], lo[3], hi[0], hi[1], hi[2], hi[3]}; }
__device__ __forceinline__ float wave_sum(float v) {
#pragma unroll
    for (int o = 1; o < 64; o <<= 1) v += __shfl_xor(v, o);
    return v;
}
__device__ __forceinline__ unsigned opq(unsigned v) { return v; }
#define LDS_WAIT() asm volatile("s_waitcnt lgkmcnt(0)" ::: "memory")
#define MFMA16(a, b, c) __builtin_amdgcn_mfma_f32_16x16x32_bf16((a), (b), (c), 0, 0, 0)

constexpr int TP = 16384, TSM = 1024, T = TP + TSM, DM = 1024;
constexpr int NZX = 6144, NINP = 6400, DIN = 2048, CONVD = 4096;
constexpr float EPS = 1e-5f;
constexpr float QSCALE = 0.0625f * 1.4426950408889634f;

__device__ __forceinline__ float row_rstd(const float* ssq, int row) {
    const f32x4* p = (const f32x4*)(ssq + (size_t)row * 16);
    const f32x4 a = p[0], b = p[1], c = p[2], d = p[3];
    const f32x4 s = (a + b) + (c + d);
    return rsqrtf(((s[0] + s[1]) + (s[2] + s[3])) * (1.0f / 1024.0f) + EPS);
}

constexpr int RSTD_TAB_OFF = 132096, RSTD_TAB_UNITS = 8;
template <class Sched> __device__ __forceinline__ void fill_rstd_table(LAS unsigned char* lds, const Sched& S, const float* ssq) {
    LAS float* tab = (LAS float*)(lds + RSTD_TAB_OFF);
    const int tid = opqv((int)threadIdx.x), r = tid >> 1, hf = tid & 1;
    pg8::Unit u;
    for (int i = 0; i < RSTD_TAB_UNITS && S.next(i, u); ++i) {
        const f32x4* p = (const f32x4*)(ssq + (size_t)(u.pm * 256 + r) * 16 + hf * 8);
        const f32x4 a = p[0], b = p[1]; const f32x4 sv = a + b;
        float t = (sv[0] + sv[1]) + (sv[2] + sv[3]); t += __shfl_xor(t, 1);
        if (hf == 0) tab[i * 256 + r] = rsqrtf(t * (1.0f / 1024.0f) + EPS);
    }
    __syncthreads();
}

struct EpiInProj {
    static constexpr bool PERM = true, AFTER_DRAIN = false;
    bf16_t* ZX; float* DT; LAS const float* tab; mutable int ui;
    __device__ __forceinline__ void operator()(const f32x4 (&acc)[2][2][4][2], const Unit& u, int wr, int wc, int fr, int fq) const {
        const int row0 = u.pm * 256 + wr * 64 + fr;
        const bool last = (u.pn == 24);
        LAS const float* tb = tab + ui * 256 + wr * 64 + fr; ++ui;
        if (last && wc != 0) return;
#pragma unroll
        for (int ai = 0; ai < 2; ++ai)
#pragma unroll
            for (int m = 0; m < 4; ++m) {
                const int row = row0 + ai * 128 + m * 16;
                const float r = tb[ai * 128 + m * 16];
                if (!last) {
                    bf16_t* rowp = ZX + (size_t)row * NZX + u.pn * 256 + wc * 32 + 8 * fq;
#pragma unroll
                    for (int bj = 0; bj < 2; ++bj) {
                        const f32x4 v0 = acc[ai][bj][m][0] * r, v1 = acc[ai][bj][m][1] * r;
                        u32x4 w; w.x = pk(v0[0], v0[1]); w.y = pk(v0[2], v0[3]); w.z = pk(v1[0], v1[1]); w.w = pk(v1[2], v1[3]);
                        *(u32x4*)(rowp + bj * 128) = w;
                    }
                } else {
                    float* dp = DT + (size_t)row * 32 + 8 * fq;
                    *(f32x4*)(dp) = acc[ai][0][m][0] * r; *(f32x4*)(dp + 4) = acc[ai][0][m][1] * r;
                }
                asm volatile("" ::: "memory");
            }
    }
};

template <int ACT> struct EpiScaleBf16 {
    static constexpr bool PERM = true, AFTER_DRAIN = false;
    bf16_t* O; int ldc; LAS const float* tab; mutable int ui;
    __device__ __forceinline__ void operator()(const f32x4 (&acc)[2][2][4][2], const Unit& u, int wr, int wc, int fr, int fq) const {
        const int row0 = u.pm * 256 + wr * 64 + fr;
        LAS const float* tb = tab + ui * 256 + wr * 64 + fr; ++ui;
#pragma unroll
        for (int ai = 0; ai < 2; ++ai)
#pragma unroll
            for (int m = 0; m < 4; ++m) {
                const int row = row0 + ai * 128 + m * 16;
                const float r = tb[ai * 128 + m * 16];
                bf16_t* rowp = O + (size_t)row * ldc + u.pn * 256 + wc * 32 + 8 * fq;
#pragma unroll
                for (int bj = 0; bj < 2; ++bj) {
                    f32x4 v0 = acc[ai][bj][m][0] * r, v1 = acc[ai][bj][m][1] * r;
                    if (ACT == 1) {
#pragma unroll
                        for (int j = 0; j < 4; ++j) { const float a0 = fmaxf(v0[j], 0.f), a1 = fmaxf(v1[j], 0.f); v0[j] = a0 * a0; v1[j] = a1 * a1; }
                    }
                    u32x4 w; w.x = pk(v0[0], v0[1]); w.y = pk(v0[2], v0[3]); w.z = pk(v1[0], v1[1]); w.w = pk(v1[2], v1[3]);
                    *(u32x4*)(rowp + bj * 128) = w;
                }
                asm volatile("" ::: "memory");
            }
    }
};

struct EpiMemKV {
    static constexpr bool PERM = true, AFTER_DRAIN = false;
    float* outK; const float* rstd; int layer; bf16_t* kvb;
    __device__ __forceinline__ void operator()(const f32x4 (&acc)[2][2][4][2], const Unit& u, int wr, int wc, int fr, int fq) const {
        const int row0 = u.pm * 256 + wr * 64 + fr;
        float* base = outK + (size_t)((u.pn >> 2) & 1) * 4194304 + (size_t)layer * (2048 * 1024) + (u.pn & 3) * 256 + wc * 32 + 8 * fq;
#pragma unroll
        for (int ai = 0; ai < 2; ++ai)
#pragma unroll
            for (int m = 0; m < 4; ++m) {
                const int row = row0 + ai * 128 + m * 16;
                const float r = rstd[row];
                float* rowp = base + (size_t)row * 1024;
                bf16_t* rowb = kvb + ((size_t)(layer * 2 + ((u.pn >> 2) & 1)) * 2048 + row) * 1024 + (u.pn & 3) * 256 + wc * 32 + 8 * fq;
#pragma unroll
                for (int bj = 0; bj < 2; ++bj) {
                    const f32x4 v0 = acc[ai][bj][m][0] * r, v1 = acc[ai][bj][m][1] * r;
                    *(f32x4*)(rowp + bj * 128) = v0; *(f32x4*)(rowp + bj * 128 + 4) = v1;
                    u32x4 wv; wv.x = pk(v0[0], v0[1]); wv.y = pk(v0[2], v0[3]); wv.z = pk(v1[0], v1[1]); wv.w = pk(v1[2], v1[3]);
                    *(u32x4*)(rowb + bj * 128) = wv;
                }
                asm volatile("" ::: "memory");
            }
    }
};

template <bool BASE_F32> struct EpiResidT {
    static constexpr bool PERM = false, AFTER_DRAIN = false;
    const float* base_p; const float* base_s; bf16_t* XB; float* ssq;
    __device__ __forceinline__ f32x4 ldb(const float* bf, size_t off) const {
        if constexpr (BASE_F32) return *(const f32x4*)(bf + off);
        else { const u32x2 v = *(const u32x2*)(XB + off); return (f32x4){bflo(v.x), bfhi(v.x), bflo(v.y), bfhi(v.y)}; }
    }
    __device__ __forceinline__ void operator()(const f32x4 (&acc)[2][2][4][2], const Unit& u, int wr, int wc, int fr, int fq) const {
        const float* bf = BASE_F32 ? base_p + ((u.pm < 64) ? (ptrdiff_t)0 : (base_s - base_p)) : (const float*)nullptr;
        const int row0 = u.pm * 256 + wr * 64 + fr, col0 = u.pn * 256 + wc * 32 + 4 * fq;
        f32x4 nb[2][2];
#pragma unroll
        for (int bj = 0; bj < 2; ++bj)
#pragma unroll
            for (int n = 0; n < 2; ++n) nb[bj][n] = ldb(bf, (size_t)row0 * 1024 + col0 + bj * 128 + n * 16);
#pragma unroll
        for (int ai = 0; ai < 2; ++ai)
#pragma unroll
            for (int m = 0; m < 4; ++m) {
                const int row = row0 + ai * 128 + m * 16;
                const size_t off = (size_t)row * 1024 + col0;
                f32x4 cb[2][2];
#pragma unroll
                for (int bj = 0; bj < 2; ++bj)
#pragma unroll
                    for (int n = 0; n < 2; ++n) cb[bj][n] = nb[bj][n];
                if (ai * 4 + m < 7) { const int rn = ai * 4 + m + 1; const size_t offn = (size_t)(row0 + (rn >> 2) * 128 + (rn & 3) * 16) * 1024 + col0;
#pragma unroll
                    for (int bj = 0; bj < 2; ++bj)
#pragma unroll
                        for (int n = 0; n < 2; ++n) nb[bj][n] = ldb(bf, offn + bj * 128 + n * 16); }
                float sq = 0.f;
#pragma unroll
                for (int bj = 0; bj < 2; ++bj)
#pragma unroll
                    for (int n = 0; n < 2; ++n) {
                        const f32x4 x = cb[bj][n] + acc[ai][bj][m][n];
                        sq += (x[0] * x[0] + x[1] * x[1]) + (x[2] * x[2] + x[3] * x[3]);
                        u32x2 w; w.x = pk(x[0], x[1]); w.y = pk(x[2], x[3]);
                        *(u32x2*)(XB + off + bj * 128 + n * 16) = w;
                    }
                sq += __shfl_xor(sq, 16); sq += __shfl_xor(sq, 32);
                if (fq == 0) ssq[(size_t)row * 16 + u.pn * 4 + wc] = sq;
                asm volatile("" ::: "memory");
            }
    }
};

constexpr size_t MiB = 1u << 20;
constexpr size_t WS_CTL = 0, CTL_ZERO_BYTES = 32768;
constexpr size_t WS_WIN = 1 * MiB, WS_WOUT = 14 * MiB, WS_WQ = 18 * MiB, WS_WKV = 22 * MiB, WS_WO = 30 * MiB, WS_WUP = 34 * MiB, WS_WDN = 50 * MiB, WS_WPOOL = 66 * MiB;
constexpr size_t WS_MEMB = 67 * MiB, WS_MEMR = 71 * MiB, WS_SSQ = 72 * MiB, WS_SSQH = 74 * MiB, WS_DT = 77 * MiB;
constexpr size_t WS_XB = 80 * MiB, WS_QB = 114 * MiB, WS_OB = 148 * MiB, WS_YG = 182 * MiB, WS_ZX = 250 * MiB, WS_ACT = 454 * MiB, WS_HB = 590 * MiB, WS_KVB = 726 * MiB, WS_END = 742 * MiB;
constexpr size_t OUT_X = 0, OUT_MK = 17825792, OUT_MV = 22020096, OUT_SSMP = 26214400, OUT_CONVP = 28311552, OUT_POOLP = 28409856, OUT_SSMS = 28532736, OUT_CONVS = 62087168, OUT_POOLS = 63660032, OUT_TOTAL = 65626112;

constexpr int NWAVES = 8, NTHR = 512;
constexpr int RING_BYTES = 131072, LDS_BYTES = 153600 + 256, MISC_OFF = 150 * 1024;
constexpr int CW_BAR = 4096;

#define XB_TMO      128
#define XB_XCNT(j)  (256  + 64 * (j))
#define XB_XSUB(j)  (1280 + 64 * (j))
#define XB_XGEN(j)  (2304 + 64 * (j))
#define XB_TOP      3328
#define XB_TOPGEN   3392
#define XCD_BAR_WORDS 3456
#define XB_SPIN_CAP (1u << 18)
__device__ __forceinline__ unsigned xb_ld(unsigned* p)              { return __hip_atomic_load(p, __ATOMIC_RELAXED, __HIP_MEMORY_SCOPE_AGENT); }
__device__ __forceinline__ unsigned xb_add(unsigned* p, unsigned v) { return __hip_atomic_fetch_add(p, v, __ATOMIC_RELAXED, __HIP_MEMORY_SCOPE_AGENT); }
__device__ __forceinline__ unsigned xb_xcc_id() { return (unsigned)__builtin_amdgcn_s_getreg((3 << 11) | 20) & 0xFu; }
#define XB_SPIN(cond, bar) do { unsigned _sp = 0; while (cond) { __builtin_amdgcn_s_sleep(1); \
    if ((++_sp & 255u) == 0u) { if (xb_ld(&(bar)[XB_TMO])) break; if (_sp > XB_SPIN_CAP) { atomicAdd(&(bar)[XB_TMO], 1u); break; } } } } while (0)
struct XcdBarrier { unsigned* bar; unsigned x; volatile LAS unsigned* st; };
__device__ __forceinline__ XcdBarrier xcd_barrier_post(unsigned* bar, volatile LAS unsigned* st) {
    XcdBarrier b; b.bar = bar; b.x = xb_xcc_id(); b.st = st;
    if (threadIdx.x == 0) (void)xb_add(&bar[XB_XCNT(b.x)], 1u);
    return b;
}
__device__ __forceinline__ void xcd_barrier_complete(unsigned* bar, unsigned x, unsigned& nloc, unsigned& nx) {
    const unsigned G = gridDim.x * gridDim.y * gridDim.z;
    unsigned sum, cnt, mine, sp = 0u;
    for (;;) {
        sum = 0u; cnt = 0u; mine = 0u;
#pragma unroll
        for (unsigned j = 0; j < 16; ++j) { const unsigned c = xb_ld(&bar[XB_XCNT(j)]); sum += c; cnt += (c > 0u) ? 1u : 0u; mine = (j == x) ? c : mine; }
        if (sum == G) break;
        __builtin_amdgcn_s_sleep(1);
        if ((++sp & 255u) == 0u) { if (xb_ld(&bar[XB_TMO])) break; if (sp > XB_SPIN_CAP) { atomicAdd(&bar[XB_TMO], 1u); break; } }
    }
    nloc = mine > 0u ? mine : 1u; nx = cnt > 0u ? cnt : 1u;
}
__device__ __forceinline__ void xcd_barrier(const XcdBarrier& b) {
    asm volatile("s_waitcnt vmcnt(0)" ::: "memory");
    __syncthreads();
    if (threadIdx.x == 0) {
        unsigned* bar = b.bar;
        __builtin_amdgcn_s_waitcnt(0);
        unsigned nloc = b.st[0], nx = b.st[1];
        if (nloc == 0u) { xcd_barrier_complete(bar, b.x, nloc, nx); b.st[0] = nloc; b.st[1] = nx; }
        const unsigned old = xb_add(&bar[XB_XSUB(b.x)], 1u);
        const unsigned gen = old / nloc;
        if (old + 1u == (gen + 1u) * nloc) {
            __builtin_amdgcn_fence(__ATOMIC_RELEASE, "agent");
            asm volatile("s_waitcnt vmcnt(0)" ::: "memory");
            const unsigned og = xb_add(&bar[XB_TOP], 1u);
            const unsigned tg = og / nx;
            if (og + 1u == (tg + 1u) * nx) xb_add(&bar[XB_TOPGEN], 1u);
            else XB_SPIN(xb_ld(&bar[XB_TOPGEN]) == tg, bar);
            __builtin_amdgcn_fence(__ATOMIC_ACQUIRE, "agent");
            xb_add(&bar[XB_XGEN(b.x)], 1u);
            asm volatile("s_waitcnt vmcnt(0)" ::: "memory");
        } else {
            XB_SPIN(xb_ld(&bar[XB_XGEN(b.x)]) == gen, bar);
            __builtin_amdgcn_fence(__ATOMIC_ACQUIRE, "agent");
            asm volatile("s_waitcnt vmcnt(0)" ::: "memory");
        }
    }
    __syncthreads();
}

struct Args { const float* in[29]; float* out; unsigned char* ws; int ph_lo, ph_hi; };
static_assert(sizeof(Args) == 31 * 8 + 8, "no padding in Args");
struct Ctx {
    LAS unsigned char* lds; unsigned char* ws; float* out;
    int tid, lane, wave, G, bid;
};
typedef const float* fptr_t;
__device__ __forceinline__ const float* karg_in(int i) {
    const __attribute__((address_space(4))) char* p = (const __attribute__((address_space(4))) char*)__builtin_amdgcn_kernarg_segment_ptr();
    asm volatile("" : "+s"(p));
    return *(const __attribute__((address_space(4))) fptr_t*)(p + 8 * i);
}
#define INP(i) karg_in(i)

__device__ __forceinline__ void transpose_item(const float* W, int K, int N, bf16_t* WT, int row_off, const float* gk, const float* gn, float cs, LAS float* scr, int item, int lane) {
    const int nblk = (N + 63) / 64, kb = item / nblk, nb = item - kb * nblk, k0 = 64 * kb, n0 = 64 * nb;
    const int n4 = (lane & 15) * 4; const bool nok = (n0 + n4) < N;
    f32x4 v[16];
#pragma unroll
    for (int i = 0; i < 16; ++i) { const int kk = 4 * i + (lane >> 4); v[i] = nok ? *(const f32x4*)(W + (size_t)(k0 + kk) * N + n0 + n4) : (f32x4){0.f, 0.f, 0.f, 0.f}; }
#pragma unroll
    for (int i = 0; i < 16; ++i) { const int kk = 4 * i + (lane >> 4); const float gs = gk ? gk[k0 + kk] : 1.f; LAS float* d = scr + kk * 65 + n4;
        d[0] = v[i][0] * gs; d[1] = v[i][1] * gs; d[2] = v[i][2] * gs; d[3] = v[i][3] * gs; }
    LDS_WAIT();
    const int c = lane & 7;
#pragma unroll
    for (int j = 0; j < 8; ++j) { const int n = (lane >> 3) + 8 * j; const LAS float* s = scr + (8 * c) * 65 + n; const float sc = (gn && (n0 + n) < N) ? cs * gn[n0 + n] : cs;
        u32x4 o; o.x = pk(s[0 * 65] * sc, s[1 * 65] * sc); o.y = pk(s[2 * 65] * sc, s[3 * 65] * sc); o.z = pk(s[4 * 65] * sc, s[5 * 65] * sc); o.w = pk(s[6 * 65] * sc, s[7 * 65] * sc);
        *(u32x4*)(WT + (size_t)(row_off + n0 + n) * K + k0 + 8 * c) = o; }
    LDS_WAIT();
}
__device__ __forceinline__ float row_to_bf16(const float* xrow, bf16_t* orow, int lane) {
    const f32x4* xr = (const f32x4*)xrow + lane; u32x2* o8 = (u32x2*)orow + lane;
    float s = 0.f;
#pragma unroll
    for (int j = 0; j < 4; ++j) { const f32x4 v = xr[64 * j]; s += (v[0] * v[0] + v[1] * v[1]) + (v[2] * v[2] + v[3] * v[3]); u32x2 w; w.x = pk(v[0], v[1]); w.y = pk(v[2], v[3]); o8[64 * j] = w; }
    return wave_sum(s);
}
template <int SET>
__device__ __forceinline__ void convert_weights(Ctx& C, int gw, int NGW) {
    LAS float* scr = (LAS float*)(C.lds + C.wave * 17408);
    unsigned char* ws = C.ws;
    constexpr int I_IN = 16 * 97, I_OUT = 32 * 16, I_SQ = 16 * 16, I_UP = 16 * 64, I_DN = 64 * 16, I_PL = 4 * 4;
    constexpr int NITEMS = SET == 0 ? I_IN + I_OUT + I_SQ + 4 * I_SQ + I_SQ : (SET == 1 ? I_SQ + I_SQ + I_UP + I_DN + 4 * I_PL + I_DN : I_UP);
    for (int it = gw; it < NITEMS; it += NGW) {
        int r = it; const float* W; int K, N, roff = 0; bf16_t* WT; const float* gk = nullptr; const float* gn = nullptr; float cs = 1.f;
        if (SET == 0) {
            if (r < I_IN) { W = INP(13); K = 1024; N = 6176; WT = (bf16_t*)(ws + WS_WIN); gk = INP(8); }
            else if ((r -= I_IN) < I_OUT) { W = INP(20); K = 2048; N = 1024; WT = (bf16_t*)(ws + WS_WOUT); gk = INP(19); }
            else if ((r -= I_OUT) < I_SQ) { W = INP(23); K = 1024; N = 1024; WT = (bf16_t*)(ws + WS_WQ); gk = INP(9); cs = QSCALE; }
            else if ((r -= I_SQ) < 4 * I_SQ) { const int i = r / I_SQ; r -= i * I_SQ; const int ly = i >> 1, kv = i & 1; W = (kv ? INP(25) : INP(24)) + (size_t)ly * 1048576; K = 1024; N = 1024; WT = (bf16_t*)(ws + WS_WKV); roff = i * 1024; gk = INP(10) + ly * 1024; }
            else { r -= 4 * I_SQ; W = INP(26); K = 1024; N = 1024; WT = (bf16_t*)(ws + WS_WO); }
        } else if (SET == 2) {
            W = INP(27); K = 1024; N = 4096; WT = (bf16_t*)(ws + WS_WUP); gk = INP(11);
        } else {
            if (r < I_SQ) { W = INP(23) + 1048576; K = 1024; N = 1024; WT = (bf16_t*)(ws + WS_WQ) + 1048576; gk = INP(9) + 1024; cs = QSCALE; }
            else if ((r -= I_SQ) < I_SQ) { W = INP(26) + 1048576; K = 1024; N = 1024; WT = (bf16_t*)(ws + WS_WO) + 1048576; }
            else if ((r -= I_SQ) < I_UP) { W = INP(27) + 4194304; K = 1024; N = 4096; WT = (bf16_t*)(ws + WS_WUP) + 4194304; gk = INP(11) + 1024; }
            else if ((r -= I_UP) < I_DN) { W = INP(28) + 4194304; K = 4096; N = 1024; WT = (bf16_t*)(ws + WS_WDN) + 4194304; }
            else if ((r -= I_DN) < 4 * I_PL) { const int i = r / I_PL; r -= i * I_PL; W = INP(21) + (size_t)i * 65536; K = 256; N = 256; WT = (bf16_t*)(ws + WS_WPOOL); roff = i * 256; gn = INP(22) + i * 256; }
            else { r -= 4 * I_PL; W = INP(28); K = 4096; N = 1024; WT = (bf16_t*)(ws + WS_WDN); }
        }
        transpose_item(W, K, N, WT, roff, gk, gn, cs, scr, r, opqv(C.tid) & 63);
    }
}
__device__ __forceinline__ void p_prologue(Ctx& C) {
    const int gw = C.bid * NWAVES + C.wave, NGW = C.G * NWAVES;
    unsigned char* ws = C.ws;
    convert_weights<0>(C, gw, NGW);
    { u32x4* z = (u32x4*)((bf16_t*)(ws + WS_WIN) + (size_t)6176 * 1024); const int n16 = (NINP - 6176) * 1024 * 2 / 16;
      for (int i = C.bid * NTHR + C.tid; i < n16; i += C.G * NTHR) z[i] = (u32x4){0u, 0u, 0u, 0u}; }
    bf16_t* XB = (bf16_t*)(ws + WS_XB); float* ssq = (float*)(ws + WS_SSQ);
    const float* xp_ = INP(0); const float* xs_ = INP(1) - (size_t)TP * 1024; const float* mem_ = INP(7);
    for (int m = gw; m < T; m += 2 * NGW) {
        const int m2 = m + NGW; const bool two = m2 < T;
        const f32x4* xr = (const f32x4*)((m < TP ? xp_ : xs_) + (size_t)m * 1024) + C.lane;
        const f32x4* xr2 = (const f32x4*)((m2 < TP ? xp_ : xs_) + (size_t)(two ? m2 : m) * 1024) + C.lane;
        f32x4 va[4], vb[4];
#pragma unroll
        for (int j = 0; j < 4; ++j) { va[j] = xr[64 * j]; vb[j] = xr2[64 * j]; }
        float s1 = 0.f, s2 = 0.f; u32x2* o1 = (u32x2*)(XB + (size_t)m * 1024) + C.lane; u32x2* o2 = (u32x2*)(XB + (size_t)(two ? m2 : m) * 1024) + C.lane;
#pragma unroll
        for (int j = 0; j < 4; ++j) { s1 += (va[j][0] * va[j][0] + va[j][1] * va[j][1]) + (va[j][2] * va[j][2] + va[j][3] * va[j][3]); u32x2 wv; wv.x = pk(va[j][0], va[j][1]); wv.y = pk(va[j][2], va[j][3]); o1[64 * j] = wv; }
        s1 = wave_sum(s1);
        if (C.lane < 16) ssq[(size_t)m * 16 + C.lane] = (C.lane == 0) ? s1 : 0.f;
        if (two) {
#pragma unroll
            for (int j = 0; j < 4; ++j) { s2 += (vb[j][0] * vb[j][0] + vb[j][1] * vb[j][1]) + (vb[j][2] * vb[j][2] + vb[j][3] * vb[j][3]); u32x2 wv; wv.x = pk(vb[j][0], vb[j][1]); wv.y = pk(vb[j][2], vb[j][3]); o2[64 * j] = wv; }
            s2 = wave_sum(s2);
            if (C.lane < 16) ssq[(size_t)m2 * 16 + C.lane] = (C.lane == 0) ? s2 : 0.f;
        }
    }
    bf16_t* MEMB = (bf16_t*)(ws + WS_MEMB); float* memr = (float*)(ws + WS_MEMR);
    for (int m = gw; m < 2048; m += NGW) {
        const float s = row_to_bf16(mem_ + (size_t)m * 1024, MEMB + (size_t)m * 1024, C.lane);
        if (C.lane == 0) memr[m] = rsqrtf(s * (1.0f / 1024.0f) + EPS);
    }
}

__device__ __forceinline__ void p_conv(Ctx& C) {
    const bf16_t* ZX = (const bf16_t*)(C.ws + WS_ZX); bf16_t* ACT = (bf16_t*)(C.ws + WS_ACT);
    const int gt = C.bid * NTHR + C.tid, NT = C.G * NTHR;
    const int oct = gt & 511, ch0 = oct * 8;
    float w[4][8], bias[8];
    const float* cw_ = INP(14); const float* cb_ = INP(15); const float* cst_ = INP(5);
#pragma unroll
    for (int k = 0; k < 4; ++k)
#pragma unroll
        for (int i = 0; i < 8; ++i) w[k][i] = cw_[k * CONVD + ch0 + i];
#pragma unroll
    for (int i = 0; i < 8; ++i) bias[i] = cb_[ch0 + i];
    for (int id = gt; id < (T / 8) * 512; id += NT) {
        const int sidx = id >> 9, m0 = sidx * 8;
        float h0[8], h1[8], h2[8];
        if (m0 < TP) {
            if ((m0 & 2047) == 0) {
#pragma unroll
                for (int i = 0; i < 8; ++i) { h0[i] = 0.f; h1[i] = 0.f; h2[i] = 0.f; }
            } else {
                const u32x4 a = *(const u32x4*)(ZX + (size_t)(m0 - 3) * NZX + 2048 + ch0), b = *(const u32x4*)(ZX + (size_t)(m0 - 2) * NZX + 2048 + ch0), c = *(const u32x4*)(ZX + (size_t)(m0 - 1) * NZX + 2048 + ch0);
#pragma unroll
                for (int i = 0; i < 4; ++i) { h0[2 * i] = bflo(a[i]); h0[2 * i + 1] = bfhi(a[i]); h1[2 * i] = bflo(b[i]); h1[2 * i + 1] = bfhi(b[i]); h2[2 * i] = bflo(c[i]); h2[2 * i + 1] = bfhi(c[i]); }
            }
        } else {
            const float* cs = cst_ + (size_t)((m0 - TP) >> 3) * 3 * CONVD + ch0;
#pragma unroll
            for (int i = 0; i < 8; ++i) { h0[i] = cs[i]; h1[i] = cs[CONVD + i]; h2[i] = cs[2 * CONVD + i]; }
        }
        u32x4 cur[8];
#pragma unroll
        for (int t = 0; t < 8; ++t) cur[t] = __builtin_nontemporal_load((const u32x4*)(ZX + (size_t)(m0 + t) * NZX + 2048 + ch0));
#pragma unroll
        for (int t = 0; t < 8; ++t) {
            float x[8], o[8];
#pragma unroll
            for (int i = 0; i < 4; ++i) { x[2 * i] = bflo(cur[t][i]); x[2 * i + 1] = bfhi(cur[t][i]); }
#pragma unroll
            for (int i = 0; i < 8; ++i) { const float v = bias[i] + w[0][i] * h0[i] + w[1][i] * h1[i] + w[2][i] * h2[i] + w[3][i] * x[i]; o[i] = silu_f(v); h0[i] = h1[i]; h1[i] = h2[i]; h2[i] = x[i]; }
            u32x4 ov; ov.x = pk(o[0], o[1]); ov.y = pk(o[2], o[3]); ov.z = pk(o[4], o[5]); ov.w = pk(o[6], o[7]);
            *(u32x4*)(ACT + (size_t)(m0 + t) * CONVD + ch0) = ov;
        }
    }
}

constexpr int PC = 288, PX = 160;
constexpr int SP_CM = 0, SP_BM = 36864, SP_XS = 73728, SP_XW = 94208, SP_HP = 114688, SP_DTV = 133120, SP_ACS = 141312;
#ifndef SSD_PREFETCH
#define SSD_PREFETCH 1
#endif
__device__ __forceinline__ void ssd_prompt_unit(Ctx& C, int b, int h) {
    LAS unsigned char* lds = C.lds;
    const int w = C.wave, g = h >> 2;
    const bf16_t* ACT = (const bf16_t*)(C.ws + WS_ACT); const bf16_t* ZX = (const bf16_t*)(C.ws + WS_ZX); const float* DT = (const float*)(C.ws + WS_DT);
    bf16_t* YG = (bf16_t*)(C.ws + WS_YG); float* SSQH = (float*)(C.ws + WS_SSQH);
    const float a = -__expf(INP(17)[h]), dtb = INP(16)[h], dsk = INP(18)[h];
    LAS float* dtv = (LAS float*)(lds + SP_DTV); LAS float* acs = (LAS float*)(lds + SP_ACS);
    f32x4 hacc[4];
#pragma unroll
    for (int pt = 0; pt < 4; ++pt) hacc[pt] = (f32x4){0.f, 0.f, 0.f, 0.f};
    for (int i = C.tid; i < 64 * PC / 16; i += NTHR) *(LAS u32x4*)(lds + SP_HP + i * 16) = (u32x4){0u, 0u, 0u, 0u};
    {
        const int t4 = C.tid * 4, lane = C.lane; float d[4], cs[4]; float run = 0.f;
#pragma unroll
        for (int i = 0; i < 4; ++i) { d[i] = softplus_f(DT[(size_t)(b * 2048 + t4 + i) * 32 + h] + dtb); run += d[i] * a; cs[i] = run; }
        float ps = run;
#pragma unroll
        for (int o = 1; o < 32; o <<= 1) { const float t = __shfl_up(ps, o, 32); if ((lane & 31) >= o) ps += t; }
        const float ex = ps - run;
        *(LAS f32x4*)(dtv + t4) = (f32x4){d[0], d[1], d[2], d[3]}; *(LAS f32x4*)(acs + t4) = (f32x4){ex + cs[0], ex + cs[1], ex + cs[2], ex + cs[3]};
    }
    __syncthreads();
    int l16 = 0, kq = 0;
    u32x4 v[10]; u32x2 zv[4];
#define SSD_LOAD(cn) do { const int row0n = b * 2048 + (cn) * 128; \
        _Pragma("unroll") for (int k = 0; k < 2; ++k) { const int id = tid + 512 * k; v[k] = *(const u32x4*)(ACT + (size_t)(row0n + (id >> 3)) * CONVD + h * 64 + (id & 7) * 8); } \
        _Pragma("unroll") for (int k = 0; k < 4; ++k) { const int id = tid + 512 * k; v[2 + k] = *(const u32x4*)(ACT + (size_t)(row0n + (id >> 4)) * CONVD + 2048 + g * 128 + (id & 15) * 8); \
                                                         v[6 + k] = *(const u32x4*)(ACT + (size_t)(row0n + (id >> 4)) * CONVD + 3072 + g * 128 + (id & 15) * 8); } \
        _Pragma("unroll") for (int pt = 0; pt < 4; ++pt) zv[pt] = *(const u32x2*)(ZX + (size_t)(row0n + 16 * w + l16) * NZX + h * 64 + 16 * pt + 4 * kq); } while (0)
#pragma unroll 1
    for (int c = 0; c < 16; ++c) {
        const int tid = opqv(C.tid), lane = tid & 63; l16 = lane & 15; kq = lane >> 4;
        const int row0 = b * 2048 + c * 128;
        LAS const float* dtc = dtv + c * 128; LAS const float* acc_ = acs + c * 128;
        const float aend = acc_[127];
        if (!SSD_PREFETCH || c == 0) SSD_LOAD(c);
        u32x2 zc[4];
#pragma unroll
        for (int pt = 0; pt < 4; ++pt) zc[pt] = zv[pt];
#pragma unroll
        for (int k = 0; k < 2; ++k) { const int id = tid + 512 * k, s = id >> 3, cc = id & 7;
            *(LAS u32x4*)(lds + SP_XS + s * PX + cc * 16) = v[k];
            const float ws_ = dtc[s] * fexp(aend - acc_[s]); u32x4 o;
#pragma unroll
            for (int i = 0; i < 4; ++i) o[i] = pk(bflo(v[k][i]) * ws_, bfhi(v[k][i]) * ws_);
            *(LAS u32x4*)(lds + SP_XW + s * PX + cc * 16) = o; }
#pragma unroll
        for (int k = 0; k < 4; ++k) { const int id = tid + 512 * k, s = id >> 4, cc = id & 15;
            *(LAS u32x4*)(lds + SP_BM + s * PC + cc * 16) = v[2 + k]; *(LAS u32x4*)(lds + SP_CM + s * PC + cc * 16) = v[6 + k]; }
        __syncthreads();
        if (SSD_PREFETCH && c + 1 < 16) SSD_LOAD(c + 1);
        f32x4 cb[8];
        {
            bf16x8 bfr[4];
#pragma unroll
            for (int ks = 0; ks < 4; ++ks) bfr[ks] = *(LAS bf16x8*)(lds + SP_CM + (16 * w + l16) * PC + 16 * kq + 64 * ks);
#pragma unroll
            for (int st = 0; st < 8; ++st) { f32x4 acc = (f32x4){0.f, 0.f, 0.f, 0.f};
#pragma unroll
                for (int ks = 0; ks < 4; ++ks) { const bf16x8 af = *(LAS bf16x8*)(lds + SP_BM + (16 * st + l16) * PC + 16 * kq + 64 * ks); acc = MFMA16(af, bfr[ks], acc); }
                cb[st] = acc; }
        }
        {
            const float dec = fexp(aend);
#pragma unroll
            for (int pt = 0; pt < 4; ++pt) hacc[pt] = hacc[pt] * dec;
#pragma unroll
            for (int ks = 0; ks < 4; ++ks) {
                const int srow = 32 * ks + 4 * kq + (l16 >> 2);
                const LAS unsigned char* ap = lds + SP_BM + srow * PC + (16 * w + 4 * (l16 & 3)) * 2;
                const bf16x8 af = cat8(lds_tr(ap), lds_tr(ap + 16 * PC));
                const LAS unsigned char* bp = lds + SP_XW + srow * PX + (4 * (l16 & 3)) * 2;
#pragma unroll
                for (int pt = 0; pt < 4; ++pt) { const bf16x8 bf = cat8(lds_tr(bp + 32 * pt), lds_tr(bp + 32 * pt + 16 * PX)); hacc[pt] = MFMA16(af, bf, hacc[pt]); }
            }
        }
        const int l = 16 * w + l16; const float al = acc_[l];
        bf16x8 mp[4];
#pragma unroll
        for (int ks = 0; ks < 4; ++ks) { u32x4 pw;
#pragma unroll
            for (int hh = 0; hh < 2; ++hh) { const int st = 2 * ks + hh, s0 = 16 * st + 4 * kq; const f32x4 as4 = *(LAS const f32x4*)(acc_ + s0), dt4 = *(LAS const f32x4*)(dtc + s0); float mv[4];
#pragma unroll
                for (int j = 0; j < 4; ++j) mv[j] = (s0 + j <= l) ? cb[st][j] * fexp(al - as4[j]) * dt4[j] : 0.f;
                pw[2 * hh] = pk(mv[0], mv[1]); pw[2 * hh + 1] = pk(mv[2], mv[3]); }
            mp[ks] = __builtin_bit_cast(bf16x8, pw); }
        {
            const int row = row0 + l;
            f32x4 y[4];
#pragma unroll
            for (int pt = 0; pt < 4; ++pt) y[pt] = (f32x4){0.f, 0.f, 0.f, 0.f};
#pragma unroll
            for (int ks = 0; ks < 4; ++ks) { const bf16x8 bf = *(LAS bf16x8*)(lds + SP_CM + l * PC + (32 * ks + 8 * kq) * 2);
                const LAS unsigned char* hp = lds + SP_HP + l16 * PC + (32 * ks + 8 * kq) * 2;
#pragma unroll
                for (int pt = 0; pt < 4; ++pt) { const bf16x8 af = *(LAS bf16x8*)(hp + 16 * pt * PC); y[pt] = MFMA16(af, bf, y[pt]); } }
            const float el = fexp(al);
#pragma unroll
            for (int pt = 0; pt < 4; ++pt) y[pt] = y[pt] * el;
            const int nk = (w >> 1) + 1;
#pragma unroll
            for (int ks = 0; ks < 4; ++ks) if (ks < nk) {
                const LAS unsigned char* ap = lds + SP_XS + (32 * ks + 4 * kq + (l16 >> 2)) * PX + (4 * (l16 & 3)) * 2;
#pragma unroll
                for (int pt = 0; pt < 4; ++pt) { const bf16x8 af = cat8(lds_tr(ap + 32 * pt), lds_tr(ap + 32 * pt + 16 * PX)); y[pt] = MFMA16(af, mp[ks], y[pt]); } }
            float ss = 0.f;
#pragma unroll
            for (int pt = 0; pt < 4; ++pt) {
                const u32x2 xv = *(LAS u32x2*)(lds + SP_XS + l * PX + (16 * pt + 4 * kq) * 2);
                const u32x2 zz = zc[pt];
                const float x0 = bflo(xv.x), x1 = bfhi(xv.x), x2 = bflo(xv.y), x3 = bfhi(xv.y);
                const float o0 = (y[pt][0] + dsk * x0) * silu_f(bflo(zz.x)), o1 = (y[pt][1] + dsk * x1) * silu_f(bfhi(zz.x));
                const float o2 = (y[pt][2] + dsk * x2) * silu_f(bflo(zz.y)), o3 = (y[pt][3] + dsk * x3) * silu_f(bfhi(zz.y));
                ss += (o0 * o0 + o1 * o1) + (o2 * o2 + o3 * o3);
                u32x2 o; o.x = pk(o0, o1); o.y = pk(o2, o3);
                *(u32x2*)(YG + (size_t)row * DIN + h * 64 + 16 * pt + 4 * kq) = o;
            }
            ss += __shfl_xor(ss, 16); ss += __shfl_xor(ss, 32);
            if (kq == 0) SSQH[(size_t)row * 32 + h] = ss;
        }
        __syncthreads();
#pragma unroll
        for (int pt = 0; pt < 4; ++pt) { u32x2 o; o.x = pk(hacc[pt][0], hacc[pt][1]); o.y = pk(hacc[pt][2], hacc[pt][3]);
            *(LAS u32x2*)(lds + SP_HP + (16 * pt + l16) * PC + (16 * w + 4 * kq) * 2) = o; }
    }
#undef SSD_LOAD
    float* so = C.out + OUT_SSMP + (size_t)(b * 32 + h) * 8192;
#pragma unroll
    for (int pt = 0; pt < 4; ++pt) *(f32x4*)(so + (size_t)(16 * pt + l16) * 128 + 16 * w + 4 * kq) = hacc[pt];
    __syncthreads();
}
__device__ __forceinline__ void ssd_sample_all(Ctx& C) {
    const int tid = C.tid, lane = C.lane;
    const bf16_t* ACT = (const bf16_t*)(C.ws + WS_ACT); const bf16_t* ZX = (const bf16_t*)(C.ws + WS_ZX); const float* DT = (const float*)(C.ws + WS_DT);
    bf16_t* YG = (bf16_t*)(C.ws + WS_YG); float* SSQH = (float*)(C.ws + WS_SSQH);
    const float* alog_ = INP(17); const float* dtb_ = INP(16); const float* dsk_ = INP(18); const float* stin_ = INP(4);
    const int p = tid >> 3, n0 = (tid & 7) * 16;
    constexpr int ARR = 12544;
    f32x4 hn[4]; unsigned short an[5]; unsigned short zn = 0; float dtn = 0.f;
#define SLOAD(uu) do { const int b_ = (uu) >> 5, h_ = (uu) & 31, g_ = h_ >> 2, m0_ = TP + b_ * 8; const float* sp_ = stin_ + (size_t)(b_ * 32 + h_) * 8192 + p * 128 + n0; \
        _Pragma("unroll") for (int i = 0; i < 4; ++i) hn[i] = __builtin_nontemporal_load((const f32x4*)(sp_ + 4 * i)); \
        an[0] = ACT[(size_t)(m0_ + (tid >> 6)) * CONVD + h_ * 64 + (tid & 63)]; \
        _Pragma("unroll") for (int k = 0; k < 2; ++k) { const int q = tid + 512 * k; an[1 + k] = ACT[(size_t)(m0_ + (q >> 7)) * CONVD + 2048 + g_ * 128 + (q & 127)]; an[3 + k] = ACT[(size_t)(m0_ + (q >> 7)) * CONVD + 3072 + g_ * 128 + (q & 127)]; } \
        zn = ZX[(size_t)(m0_ + (tid >> 6)) * NZX + h_ * 64 + (tid & 63)]; if (tid < 8) dtn = DT[(size_t)(m0_ + tid) * 32 + h_]; } while (0)
    int u = C.bid; if (u >= 4096) return;
    SLOAD(u);
    int par = 0;
#pragma unroll 1
    for (; u < 4096; u += C.G) {
        const int b = u >> 5, h = u & 31, m0 = TP + b * 8;
        const float a = -__expf(alog_[h]), dtb = dtb_[h], dsk = dsk_[h];
        LAS float* xs = (LAS float*)(C.lds + par * ARR); LAS float* Bs = xs + 512; LAS float* Cs = Bs + 1024; LAS float* yv = Cs + 1024; LAS float* dts = yv + 512;
        xs[tid] = __uint_as_float((unsigned)an[0] << 16);
#pragma unroll
        for (int k = 0; k < 2; ++k) { Bs[tid + 512 * k] = __uint_as_float((unsigned)an[1 + k] << 16); Cs[tid + 512 * k] = __uint_as_float((unsigned)an[3 + k] << 16); }
        if (tid < 8) { const float d = softplus_f(dtn + dtb); dts[tid] = d; dts[8 + tid] = __expf(d * a); }
        f32x4 hs[4];
#pragma unroll
        for (int i = 0; i < 4; ++i) hs[i] = hn[i];
        const float z = __uint_as_float((unsigned)zn << 16);
        __syncthreads();
        if (u + C.G < 4096) SLOAD(u + C.G);
#pragma unroll
        for (int t = 0; t < 8; ++t) {
            const float dec = dts[8 + t], dtx = dts[t] * xs[t * 64 + p];
            float yp = 0.f;
#pragma unroll
            for (int i = 0; i < 4; ++i) { const f32x4 bv = *(LAS f32x4*)(Bs + t * 128 + n0 + 4 * i), cv = *(LAS f32x4*)(Cs + t * 128 + n0 + 4 * i);
                hs[i] = hs[i] * dec + bv * dtx; yp += (hs[i][0] * cv[0] + hs[i][1] * cv[1]) + (hs[i][2] * cv[2] + hs[i][3] * cv[3]); }
            yp += __shfl_xor(yp, 1); yp += __shfl_xor(yp, 2); yp += __shfl_xor(yp, 4);
            if ((tid & 7) == 0) yv[t * 64 + p] = yp;
        }
        float* so = C.out + OUT_SSMS + (size_t)(b * 32 + h) * 8192 + p * 128 + n0;
#pragma unroll
        for (int i = 0; i < 4; ++i) __builtin_nontemporal_store(hs[i], (f32x4*)(so + 4 * i));
        __syncthreads();
        {
            const int t = tid >> 6, pp = tid & 63, row = m0 + t;
            const float o = (yv[tid] + dsk * xs[tid]) * silu_f(z);
            YG[(size_t)row * DIN + h * 64 + pp] = (bf16_t)(pk(o, 0.f) & 0xffffu);
            const float ss = wave_sum(o * o);
            if (lane == 0) SSQH[(size_t)row * 32 + h] = ss;
        }
        par ^= 1;
    }
#undef SLOAD
    __syncthreads();
}
__device__ __forceinline__ void p_ssd(Ctx& C) {
    for (int u = C.bid; u < 256; u += C.G) ssd_prompt_unit(C, u >> 5, u & 31);
    ssd_sample_all(C);
}

__device__ __forceinline__ void p_gnorm(Ctx& C) {
    bf16_t* YG = (bf16_t*)(C.ws + WS_YG); const float* SSQH = (const float*)(C.ws + WS_SSQH); const bf16_t* ZX = (const bf16_t*)(C.ws + WS_ZX);
    const int gw = C.bid * NWAVES + C.wave, NGW = C.G * NWAVES, lane = C.lane;
    for (int m0 = gw; m0 < T; m0 += 2 * NGW) {
        u32x4 v[2][4]; f32x4 q[2][4];
#pragma unroll
        for (int rr = 0; rr < 2; ++rr) { const int m = (m0 + rr * NGW < T) ? m0 + rr * NGW : m0; const u32x4* rp = (const u32x4*)(YG + (size_t)m * DIN);
#pragma unroll
            for (int i = 0; i < 4; ++i) { const int c = lane + 64 * i; q[rr][i] = *(const f32x4*)(SSQH + (size_t)m * 32 + 4 * (c >> 5)); v[rr][i] = rp[c]; } }
#pragma unroll
        for (int rr = 0; rr < 2; ++rr) if (rr == 0 || m0 + NGW < T) { const int m = m0 + rr * NGW; u32x4* rp = (u32x4*)(YG + (size_t)m * DIN);
#pragma unroll
            for (int i = 0; i < 4; ++i) { const int c = lane + 64 * i; const f32x4 qq = q[rr][i];
                const float r = rsqrtf(((qq[0] + qq[1]) + (qq[2] + qq[3])) * (1.0f / 256.0f) + EPS);
                u32x4 o = v[rr][i];
#pragma unroll
                for (int k = 0; k < 4; ++k) o[k] = pk(bflo(o[k]) * r, bfhi(o[k]) * r);
                rp[c] = o; } }
    }
    for (int r = C.bid; r < 408; r += C.G) {
        const int sq = r / 3, k = r - 3 * sq;
        const int row = sq < 8 ? sq * 2048 + 2045 + k : TP + (sq - 8) * 8 + 5 + k;
        float* o = sq < 8 ? C.out + OUT_CONVP + (size_t)(sq * 3 + k) * CONVD : C.out + OUT_CONVS + (size_t)((sq - 8) * 3 + k) * CONVD;
        const u32x4 v = *(const u32x4*)(ZX + (size_t)row * NZX + 2048 + C.tid * 8);
        *(f32x4*)(o + C.tid * 8) = (f32x4){bflo(v.x), bfhi(v.x), bflo(v.y), bfhi(v.y)};
        *(f32x4*)(o + C.tid * 8 + 4) = (f32x4){bflo(v.z), bfhi(v.z), bflo(v.w), bfhi(v.w)};
    }
}

constexpr int KP = 544, VP = 544;
__device__ __forceinline__ void stage_kv(LAS unsigned char* lds, const float* G, int pitch, int tid) {
#pragma unroll 1
    for (int it = 0; it < 32; it += 8) {
        f32x4 v[8];
#pragma unroll
        for (int u = 0; u < 8; ++u) { const int idx = (it + u) * 512 + tid; v[u] = __builtin_nontemporal_load((const f32x4*)(G + (size_t)(idx >> 6) * 1024 + (idx & 63) * 4)); }
#pragma unroll
        for (int u = 0; u < 8; ++u) { const int idx = (it + u) * 512 + tid; u32x2 o; o.x = pk(v[u][0], v[u][1]); o.y = pk(v[u][2], v[u][3]);
            *(LAS u32x2*)(lds + (idx >> 6) * pitch + (idx & 63) * 8) = o; }
    }
}
__device__ __forceinline__ void stage_kv_bf(LAS unsigned char* lds, const bf16_t* G, int pitch, int tid) {
#pragma unroll 1
    for (int it = 0; it < 16; it += 8) {
        u32x4 v[8];
#pragma unroll
        for (int u = 0; u < 8; ++u) { const int idx = (it + u) * 512 + tid; v[u] = *(const u32x4*)(G + (size_t)(idx >> 5) * 1024 + (idx & 31) * 8); }
#pragma unroll
        for (int u = 0; u < 8; ++u) { const int idx = (it + u) * 512 + tid; *(LAS u32x4*)(lds + (idx >> 5) * pitch + (idx & 31) * 16) = v[u]; }
    }
}
template <bool PROMPT>
__device__ __forceinline__ void attn_unit(Ctx& C, const void* Kg, const void* Vg, const bf16_t* Qg, bf16_t* Og) {
    constexpr int NRS = PROMPT ? 2 : 1, nrows = PROMPT ? 256 : 8;
    LAS unsigned char* lds = C.lds;
    const int tid = opqv(C.tid), lane = tid & 63, w = C.wave, l16 = lane & 15, kq = lane >> 4;
    const bool active = PROMPT || (w == 0);
    if (PROMPT) stage_kv_bf(lds, (const bf16_t*)Kg, KP, tid); else stage_kv(lds, (const float*)Kg, KP, tid);
    bf16x8 pf[NRS][8]; float inv[NRS];
    __syncthreads();
    if (active) {
#pragma unroll
        for (int rs = 0; rs < NRS; ++rs) {
            int q = rs * 128 + w * 16 + l16; if (q >= nrows) q = nrows - 1;
            const bf16_t* qp = Qg + (size_t)q * 1024 + 8 * kq;
            bf16x8 qf[8];
#pragma unroll
            for (int ks = 0; ks < 8; ++ks) qf[ks] = *(const bf16x8*)(qp + 32 * ks);
            f32x4 st[16];
#pragma unroll
            for (int kt = 0; kt < 16; ++kt) { f32x4 acc = (f32x4){0.f, 0.f, 0.f, 0.f};
                const unsigned ko = (unsigned)((16 * kt + l16) * KP + 16 * kq);
#pragma unroll
                for (int ks = 0; ks < 8; ++ks) { const bf16x8 af = *(LAS bf16x8*)(lds + ko + 64 * ks); acc = MFMA16(af, qf[ks], acc); }
                st[kt] = acc; asm volatile("" ::: "memory"); }
            float mx = -3.0e38f;
#pragma unroll
            for (int kt = 0; kt < 16; ++kt) mx = fmaxf(fmaxf(mx, fmaxf(st[kt][0], st[kt][1])), fmaxf(st[kt][2], st[kt][3]));
            mx = fmaxf(mx, __shfl_xor(mx, 16)); mx = fmaxf(mx, __shfl_xor(mx, 32));
            float sm = 0.f;
#pragma unroll
            for (int kt = 0; kt < 16; ++kt)
#pragma unroll
                for (int j = 0; j < 4; ++j) { const float pv = __builtin_amdgcn_exp2f(st[kt][j] - mx); st[kt][j] = pv; sm += pv; }
            sm += __shfl_xor(sm, 16); sm += __shfl_xor(sm, 32);
            inv[rs] = 1.0f / sm;
#pragma unroll
            for (int kk = 0; kk < 8; ++kk) { u32x4 pw; pw.x = pk(st[2 * kk][0], st[2 * kk][1]); pw.y = pk(st[2 * kk][2], st[2 * kk][3]); pw.z = pk(st[2 * kk + 1][0], st[2 * kk + 1][1]); pw.w = pk(st[2 * kk + 1][2], st[2 * kk + 1][3]);
                pf[rs][kk] = __builtin_bit_cast(bf16x8, pw); }
        }
    }
    __syncthreads();
    if (PROMPT) stage_kv_bf(lds, (const bf16_t*)Vg, VP, tid); else stage_kv(lds, (const float*)Vg, VP, tid);
    __syncthreads();
    if (active) {
#pragma unroll
        for (int rs = 0; rs < NRS; ++rs) {
            const int q = rs * 128 + w * 16 + l16;
#pragma unroll
            for (int dt = 0; dt < 16; ++dt) { f32x4 acc = (f32x4){0.f, 0.f, 0.f, 0.f};
#pragma unroll
                for (int kk = 0; kk < 8; ++kk) { const LAS unsigned char* ap = lds + (unsigned)((32 * kk + 4 * kq + (l16 >> 2)) * VP + (16 * dt + 4 * (l16 & 3)) * 2);
                    const bf16x8 af = cat8(lds_tr(ap), lds_tr(ap + 16 * VP)); acc = MFMA16(af, pf[rs][kk], acc); }
                if (q < nrows) { const float iv = inv[rs]; u32x2 o; o.x = pk(acc[0] * iv, acc[1] * iv); o.y = pk(acc[2] * iv, acc[3] * iv); *(u32x2*)(Og + (size_t)q * 1024 + 16 * dt + 4 * kq) = o; }
                asm volatile("" ::: "memory"); }
        }
    }
    __syncthreads();
}
__device__ __forceinline__ void p_attn(Ctx& C, int layer) {
    const bf16_t* QB = (const bf16_t*)(C.ws + WS_QB); bf16_t* OB = (bf16_t*)(C.ws + WS_OB); const bf16_t* KVB = (const bf16_t*)(C.ws + WS_KVB);
    const int cls = (C.G == 256) ? C.bid % 3 : 0;
    for (int u0 = C.bid, k = 0; u0 < 768; u0 += C.G, ++k) {
        int u = u0; if (C.G == 256) { const int kk = cls == 0 ? k : (cls == 1 ? (k == 0 ? 1 : (k == 1 ? 0 : 2)) : (k + 1) % 3); u = C.bid + 256 * kk; }
        if (u < 256) { const int qt = u & 7, h = (u >> 3) & 3, b = u >> 5;
            const size_t ko = ((size_t)(layer * 2) * 2048 + (size_t)b * 256) * 1024 + h * 256; const size_t qo = (size_t)(b * 2048 + qt * 256) * 1024 + h * 256;
            attn_unit<true>(C, KVB + ko, KVB + ko + (size_t)2048 * 1024, QB + qo, OB + qo);
        } else { const int v = u - 256, h = v & 3, b = v >> 2;
            const size_t kvo = (size_t)layer * 128 * 256 * 1024 + (size_t)b * 256 * 1024 + h * 256; const size_t qo = (size_t)(TP + b * 8) * 1024 + h * 256;
            attn_unit<false>(C, INP(2) + kvo, INP(3) + kvo, QB + qo, OB + qo);
        }
    }
}

constexpr int SG_P = 544, SG_T = 64 * SG_P, SG_RED = 4 * SG_T;
template <int MODE>
__device__ __forceinline__ void sgemm_sample(Ctx& C, const bf16_t* A, int lda, int apn, const bf16_t* Bt, int K, const float* base, float* X, bf16_t* XB, float* ssq, bf16_t* O) {
    LAS unsigned char* lds = C.lds;
    const int ns = K >> 8;
    for (int t = C.bid; t < 256; t += C.G) {
        const int tid = opqv(C.tid), lane = tid & 63, w = C.wave, l16 = lane & 15, kq = lane >> 4, wm = w & 3, wn = w >> 2;
        const int tm = t & 15, tn = t >> 4;
        const bf16_t* Ap = A + (size_t)(TP + 64 * tm) * lda + (tn >> 2) * apn;
        const bf16_t* Bp = Bt + (size_t)(64 * tn) * K;
        u32x4 ra[4], rb[4];
#pragma unroll
        for (int i = 0; i < 4; ++i) { const int id = tid + 512 * i, row = id >> 5, cc = id & 31;
            ra[i] = *(const u32x4*)(Ap + (size_t)row * lda + cc * 8); rb[i] = *(const u32x4*)(Bp + (size_t)row * K + cc * 8); }
        __syncthreads();
#pragma unroll
        for (int i = 0; i < 4; ++i) { const int id = tid + 512 * i, row = id >> 5, cc = id & 31;
            *(LAS u32x4*)(lds + row * SG_P + cc * 16) = ra[i]; *(LAS u32x4*)(lds + SG_T + row * SG_P + cc * 16) = rb[i]; }
        __syncthreads();
        f32x4 acc[2] = {(f32x4){0.f, 0.f, 0.f, 0.f}, (f32x4){0.f, 0.f, 0.f, 0.f}};
#pragma unroll 1
        for (int st = 0; st < ns; ++st) {
            const int buf = st & 1;
            if (st + 1 < ns) {
#pragma unroll
                for (int i = 0; i < 4; ++i) { const int id = tid + 512 * i, row = id >> 5, cc = id & 31;
                    ra[i] = *(const u32x4*)(Ap + (size_t)row * lda + (st + 1) * 256 + cc * 8); rb[i] = *(const u32x4*)(Bp + (size_t)row * K + (st + 1) * 256 + cc * 8); }
            }
            const LAS unsigned char* ab = lds + buf * 2 * SG_T + (16 * wm + l16) * SG_P + kq * 16;
            const LAS unsigned char* bb = lds + buf * 2 * SG_T + SG_T + (32 * wn + l16) * SG_P + kq * 16;
#pragma unroll
            for (int ks = 0; ks < 8; ++ks) { const bf16x8 af = *(LAS bf16x8*)(ab + ks * 64);
                const bf16x8 b0 = *(LAS bf16x8*)(bb + ks * 64), b1 = *(LAS bf16x8*)(bb + 16 * SG_P + ks * 64);
                acc[0] = MFMA16(b0, af, acc[0]); acc[1] = MFMA16(b1, af, acc[1]); }
            if (st + 1 < ns) {
#pragma unroll
                for (int i = 0; i < 4; ++i) { const int id = tid + 512 * i, row = id >> 5, cc = id & 31;
                    *(LAS u32x4*)(lds + (buf ^ 1) * 2 * SG_T + row * SG_P + cc * 16) = ra[i]; *(LAS u32x4*)(lds + (buf ^ 1) * 2 * SG_T + SG_T + row * SG_P + cc * 16) = rb[i]; }
            }
            __syncthreads();
        }
        const int row = TP + 64 * tm + 16 * wm + l16, col0 = 64 * tn + 32 * wn + 4 * kq;
        if (MODE == 0) {
            float sq = 0.f;
#pragma unroll
            for (int j = 0; j < 2; ++j) { const size_t off = (size_t)row * 1024 + col0 + 16 * j;
                f32x4 bv; if (base) bv = *(const f32x4*)(base + off); else { const u32x2 v = *(const u32x2*)(XB + off); bv = (f32x4){bflo(v.x), bfhi(v.x), bflo(v.y), bfhi(v.y)}; }
                const f32x4 x = bv + acc[j];
                sq += (x[0] * x[0] + x[1] * x[1]) + (x[2] * x[2] + x[3] * x[3]);
                u32x2 o; o.x = pk(x[0], x[1]); o.y = pk(x[2], x[3]); *(u32x2*)(XB + off) = o; }
            sq += __shfl_xor(sq, 16); sq += __shfl_xor(sq, 32);
            LAS float* red = (LAS float*)(lds + SG_RED);
            if (wn == 1 && kq == 0) red[16 * wm + l16] = sq;
            __syncthreads();
            if (wn == 0 && kq == 0) ssq[(size_t)row * 16 + tn] = sq + red[16 * wm + l16];
        } else {
            const float r = row_rstd(ssq, row);
#pragma unroll
            for (int j = 0; j < 2; ++j) { const f32x4 v = acc[j] * r; u32x2 o; o.x = pk(v[0], v[1]); o.y = pk(v[2], v[3]); *(u32x2*)(O + (size_t)row * 1024 + col0 + 16 * j) = o; }
        }
    }
    __syncthreads();
}

template <int W> __device__ __forceinline__ void pool_run(Ctx& C, bool sample, int b, int t0, int nrows, LAS const float* rs) {
    const int c0 = C.tid * 2;
    const bf16_t* XS = (const bf16_t*)(C.ws + WS_XB); bf16_t* PO = (bf16_t*)(C.ws + WS_OB);
    const f32x2 gm = *(const f32x2*)(INP(8) + 1024 + c0); const float* spool_ = INP(6);
    const int mbase = sample ? TP + b * 8 : b * 2048 + t0;
    f32x2 ring[16]; f32x2 S = (f32x2){0.f, 0.f};
#pragma unroll
    for (int k = 0; k < 16; ++k) ring[k] = (f32x2){0.f, 0.f};
    const int nblk = (nrows + 16 + 15) / 16;
    for (int blk = 0; blk < nblk; ++blk) {
#pragma unroll
        for (int k = 0; k < 16; ++k) {
            const int r = blk * 16 + k - 16;
            if (r < nrows) {
                f32x2 u = (f32x2){0.f, 0.f};
                if (r >= 0) { const unsigned xr = *(const unsigned*)(XS + (size_t)(mbase + r) * 1024 + c0); const f32x2 xv = (f32x2){bflo(xr), bfhi(xr)}; const float rr = rs[r + 16]; u = xv * rr * gm; }
                else if (sample) { if (r >= -15) u = *(const f32x2*)(spool_ + (size_t)(b * 15 + r + 15) * 1024 + c0); }
                else if (t0 > 0 && r >= -15) { const unsigned xr = *(const unsigned*)(XS + (size_t)(mbase + r) * 1024 + c0); const f32x2 xv = (f32x2){bflo(xr), bfhi(xr)}; const float rr = rs[r + 16]; u = xv * rr * gm; }
                S = S + u - ring[(k + 16 - W) & 15];
                ring[k] = u;
                if (r >= 0) {
                    const int pos = sample ? TP + r : t0 + r;
                    const float cnt = (float)((pos + 1) < W ? (pos + 1) : W);
                    const f32x2 pl = S * (1.0f / cnt) - u;
                    *(unsigned*)(PO + (size_t)(mbase + r) * 1024 + c0) = pk(pl[0], pl[1]);
                    if (sample) *(f32x2*)(C.out + OUT_POOLS + (size_t)(b * 15 + 7 + r) * 1024 + c0) = u;
                    else if (t0 + r >= 2033) *(f32x2*)(C.out + OUT_POOLP + (size_t)(b * 15 + (t0 + r - 2033)) * 1024 + c0) = u;
                }
            }
        }
    }
}
__device__ __forceinline__ void p_pool_elem(Ctx& C) {
    LAS float* rs = (LAS float*)C.lds;
    const float* ssq = (const float*)(C.ws + WS_SSQ);
    for (int u = C.bid; u < 256 + 128; u += C.G) {
        const bool sample = u >= 256;
        const int b = sample ? u - 256 : u >> 5, t0 = sample ? 0 : (u & 31) * 64, nrows = sample ? 8 : 64;
        const int mbase = sample ? TP + b * 8 : b * 2048 + t0;
        __syncthreads();
        if (C.tid < 80) { const int r = C.tid - 16; float v = 0.f; if (r < nrows && (r >= 0 || (!sample && t0 > 0))) v = row_rstd(ssq, mbase + r); rs[C.tid] = v; }
        __syncthreads();
        const int grp = C.tid >> 7;
        if (grp == 0) pool_run<2>(C, sample, b, t0, nrows, rs); else if (grp == 1) pool_run<4>(C, sample, b, t0, nrows, rs);
        else if (grp == 2) pool_run<8>(C, sample, b, t0, nrows, rs); else pool_run<16>(C, sample, b, t0, nrows, rs);
        if (sample) {
            const float* spool_ = INP(6);
            for (int i = C.tid; i < 7 * 256; i += NTHR) { const int j = i >> 8, c4 = (i & 255) * 4;
                *(f32x4*)(C.out + OUT_POOLS + (size_t)(b * 15 + j) * 1024 + c4) = *(const f32x4*)(spool_ + (size_t)(b * 15 + 8 + j) * 1024 + c4); }
        }
    }
}

__device__ __forceinline__ void p_final(Ctx& C) {
    float* Y = C.out + OUT_X; const bf16_t* XS = (const bf16_t*)(C.ws + WS_XB); const float* ssq = (const float*)(C.ws + WS_SSQ); const float* gf = INP(12);
    const int gw = C.bid * NWAVES + C.wave, NGW = C.G * NWAVES;
    const f32x4* gp = (const f32x4*)gf + C.lane;
    f32x4 gv[4];
#pragma unroll
    for (int j = 0; j < 4; ++j) gv[j] = gp[64 * j];
    for (int m0 = gw; m0 < T; m0 += 2 * NGW) {
        const int m1 = (m0 + NGW < T) ? m0 + NGW : m0;
        const u32x2* x0 = (const u32x2*)(XS + (size_t)m0 * 1024) + C.lane; const u32x2* x1 = (const u32x2*)(XS + (size_t)m1 * 1024) + C.lane;
        u32x2 a[4], b[4];
#pragma unroll
        for (int j = 0; j < 4; ++j) { a[j] = x0[64 * j]; b[j] = x1[64 * j]; }
        const float r0 = row_rstd(ssq, m0), r1 = row_rstd(ssq, m1);
        f32x4* y0 = (f32x4*)(Y + (size_t)m0 * 1024) + C.lane; f32x4* y1 = (f32x4*)(Y + (size_t)m1 * 1024) + C.lane;
#pragma unroll
        for (int j = 0; j < 4; ++j) y0[64 * j] = (f32x4){bflo(a[j].x), bfhi(a[j].x), bflo(a[j].y), bfhi(a[j].y)} * r0 * gv[j];
        if (m1 != m0) {
#pragma unroll
            for (int j = 0; j < 4; ++j) y1[64 * j] = (f32x4){bflo(b[j].x), bfhi(b[j].x), bflo(b[j].y), bfhi(b[j].y)} * r1 * gv[j];
        }
    }
}

constexpr int N_PHASES = 19;
#ifndef MK_MULTI
#define MK_MULTI 0
#endif
typedef pg8::StaticOrder SO;
__global__ void __launch_bounds__(NTHR, 2) fwd_kernel(Args args) {
    extern __shared__ __attribute__((aligned(16))) unsigned char lds_raw[];
    Ctx C; C.lds = (LAS unsigned char*)lds_raw; C.ws = args.ws; C.out = args.out;
    C.tid = threadIdx.x; C.lane = C.tid & 63; C.wave = __builtin_amdgcn_readfirstlane(C.tid >> 6); C.G = gridDim.x; C.bid = blockIdx.x;
    volatile LAS unsigned* MISC = (volatile LAS unsigned*)(C.lds + MISC_OFF);
    if (C.tid < 16) MISC[C.tid] = 0u;
    __syncthreads();
    const int lo = args.ph_lo, hi = args.ph_hi;
    XcdBarrier bar; bar.bar = (unsigned*)(C.ws + WS_CTL) + CW_BAR; bar.x = 0; bar.st = MISC;
    if (hi - lo > 1) bar = xcd_barrier_post((unsigned*)(C.ws + WS_CTL) + CW_BAR, MISC);
#ifndef PH_MASK
#define PH_MASK 0x7ffff
#endif
#define IN(k) (((PH_MASK >> (k)) & 1) && lo <= (k) && (k) < hi)
#ifndef REP_PHASE
#define REP_PHASE -1
#endif
#define REPN(k) for (int rep_ = 0; rep_ < ((k) == REP_PHASE ? 2 : 1); ++rep_)
#define SEAM(k) do { if (IN(k) && IN((k) + 1)) xcd_barrier(bar); } while (0)
    LAS unsigned char* ring = C.lds;
#define PHP unsigned char* ws = opqs(args.ws); float* OUTP = opqs(args.out); bf16_t* XB = (bf16_t*)(ws + WS_XB); float* SSQ = (float*)(ws + WS_SSQ); float* X = OUTP + OUT_X; (void)XB; (void)SSQ; (void)X;

    if (IN(0)) REPN(0) { p_prologue(C); } SEAM(0);
    if (IN(1)) REPN(1) {
        PHP
        pg8::Gemm g{XB, (const bf16_t*)(ws + WS_WIN), T, NINP, 1024, 1024, 0}; SO S; S.init(T, NINP, C.G, C.bid);
        fill_rstd_table(ring, S, SSQ);
        EpiInProj E{(bf16_t*)(ws + WS_ZX), (float*)(ws + WS_DT), (LAS const float*)(ring + RSTD_TAB_OFF), 0};
        pg8::gemm_phase<EpiInProj, SO, true, true>(ring, g, S, E);
        {
            pg8::Gemm g2{(const bf16_t*)(ws + WS_MEMB), (const bf16_t*)(ws + WS_WKV), 2048, 2048, 1024, 1024, 0}; SO S2; S2.init(2048, 2048, C.G, (C.bid + C.G - 192) % C.G);
            EpiMemKV E2{OUTP + OUT_MK, (const float*)(ws + WS_MEMR), 0, (bf16_t*)(ws + WS_KVB)};
            pg8::gemm_phase<EpiMemKV, SO, true, true>(ring, g2, S2, E2);
        }
        if (C.G == 256 && C.bid >= 164 && C.bid < 192) convert_weights<2>(C, (C.bid - 164) * NWAVES + C.wave, 28 * NWAVES);
        else if (C.G != 256) convert_weights<2>(C, C.bid * NWAVES + C.wave, C.G * NWAVES);
    } SEAM(1);
    if (IN(2)) REPN(2) { p_conv(C); } SEAM(2);
    if (IN(3)) REPN(3) { p_ssd(C); } SEAM(3);
    if (IN(4)) { p_gnorm(C); } SEAM(4);
    if (IN(5)) {
        PHP
        pg8::Gemm g{(const bf16_t*)(ws + WS_YG), (const bf16_t*)(ws + WS_WOUT), TP, 1024, 2048, 2048, 0}; SO S; S.init(TP, 1024, C.G, C.bid);
        const float* xs_ = INP(1) - (size_t)TP * 1024;
        EpiResidT<true> E{INP(0), xs_, XB, SSQ};
        pg8::gemm_phase<EpiResidT<true>, SO, true, true>(ring, g, S, E);
        sgemm_sample<0>(C, g.A, 2048, 0, g.Bt, 2048, xs_, nullptr, XB, SSQ, nullptr);
    } SEAM(5);
#pragma unroll 1
    for (int ly = 0; ly < 2; ++ly) {
        const int pb = ly == 0 ? 6 : 13;
        if (ly == 1) {
            if (IN(11)) { p_pool_elem(C); } SEAM(11);
            if (IN(12)) {
                PHP
                pg8::Gemm g{(const bf16_t*)(ws + WS_OB), (const bf16_t*)(ws + WS_WPOOL), TP, 1024, 256, 1024, 256}; SO S; S.init(TP, 1024, C.G, C.bid);
                EpiResidT<false> E{nullptr, nullptr, XB, SSQ};
                pg8::gemm_phase<EpiResidT<false>, SO, true, true>(ring, g, S, E);
                sgemm_sample<0>(C, g.A, 1024, 256, g.Bt, 256, nullptr, nullptr, XB, SSQ, nullptr);
            } SEAM(12);
        }
        if (IN(pb)) {
            PHP
            pg8::Gemm g{XB, (const bf16_t*)(ws + WS_WQ) + (size_t)ly * 1048576, TP, 1024, 1024, 1024, 0}; SO S; S.init(TP, 1024, C.G, C.bid);
            fill_rstd_table(ring, S, SSQ);
            EpiScaleBf16<0> E{(bf16_t*)(ws + WS_QB), 1024, (LAS const float*)(ring + RSTD_TAB_OFF), 0};
            pg8::gemm_phase<EpiScaleBf16<0>, SO, true, true>(ring, g, S, E);
            sgemm_sample<1>(C, g.A, 1024, 0, g.Bt, 1024, nullptr, nullptr, nullptr, SSQ, (bf16_t*)(ws + WS_QB));
        } SEAM(pb);
        if (IN(pb + 1)) REPN(pb + 1) { p_attn(C, ly); } SEAM(pb + 1);
        if (IN(pb + 2)) {
            PHP
            pg8::Gemm g{(const bf16_t*)(ws + WS_OB), (const bf16_t*)(ws + WS_WO) + (size_t)ly * 1048576, TP, 1024, 1024, 1024, 0}; SO S; S.init(TP, 1024, C.G, C.bid);
            EpiResidT<false> E{nullptr, nullptr, XB, SSQ};
            pg8::gemm_phase<EpiResidT<false>, SO, true, true>(ring, g, S, E);
            sgemm_sample<0>(C, g.A, 1024, 0, g.Bt, 1024, nullptr, nullptr, XB, SSQ, nullptr);
        } SEAM(pb + 2);
        if (IN(pb + 3)) REPN(pb + 3) {
            PHP
            pg8::Gemm g{XB, (const bf16_t*)(ws + WS_WUP) + (size_t)ly * 4194304, T, 4096, 1024, 1024, 0}; SO S; S.init(T, 4096, C.G, C.bid);
            fill_rstd_table(ring, S, SSQ);
            EpiScaleBf16<1> E{(bf16_t*)(ws + WS_HB), 4096, (LAS const float*)(ring + RSTD_TAB_OFF), 0};
            pg8::gemm_phase<EpiScaleBf16<1>, SO, true, true>(ring, g, S, E);
            if (ly == 0) {
                pg8::Gemm g2{(const bf16_t*)(ws + WS_MEMB), (const bf16_t*)(ws + WS_WKV) + (size_t)2048 * 1024, 2048, 2048, 1024, 1024, 0}; SO S2; S2.init(2048, 2048, C.G, (C.bid + C.G - 64) % C.G);
                EpiMemKV E2{OUTP + OUT_MK, (const float*)(ws + WS_MEMR), 1, (bf16_t*)(ws + WS_KVB)};
                pg8::gemm_phase<EpiMemKV, SO, true, true>(ring, g2, S2, E2);
                const int half = C.G / 2;
                if (C.bid >= half) convert_weights<1>(C, (C.bid - half) * NWAVES + C.wave, (C.G - half) * NWAVES);
            }
        } SEAM(pb + 3);
        if (IN(pb + 4)) {
            PHP
            pg8::Gemm g{(const bf16_t*)(ws + WS_HB), (const bf16_t*)(ws + WS_WDN) + (size_t)ly * 4194304, TP, 1024, 4096, 4096, 0}; SO S; S.init(TP, 1024, C.G, C.bid);
            EpiResidT<false> E{nullptr, nullptr, XB, SSQ};
            pg8::gemm_phase<EpiResidT<false>, SO, true, true>(ring, g, S, E);
            sgemm_sample<0>(C, g.A, 4096, 0, g.Bt, 4096, nullptr, nullptr, XB, SSQ, nullptr);
        } SEAM(pb + 4);
    }
    if (IN(18)) { p_final(C); }
#undef IN
#undef SEAM
}

extern "C" void kernel_launch(void* const* d_in, const int* in_sizes, int n_in, void* d_out, int out_size, void* d_ws, size_t ws_size, hipStream_t stream) {
    static int grid = 0;
    if (grid == 0) {
        if (n_in != 29 || out_size != (int)OUT_TOTAL || ws_size < WS_END) { fprintf(stderr, "kernel_launch: unexpected shapes: n_in %d out %d ws %zu\n", n_in, out_size, ws_size); grid = -1; return; }
        int dev = 0, cus = 0, per_cu = 0;
        if (hipGetDevice(&dev) != hipSuccess || hipDeviceGetAttribute(&cus, hipDeviceAttributeMultiprocessorCount, dev) != hipSuccess) { grid = -1; return; }
        if (hipFuncSetAttribute((const void*)fwd_kernel, hipFuncAttributeMaxDynamicSharedMemorySize, LDS_BYTES) != hipSuccess) { fprintf(stderr, "kernel_launch: hipFuncSetAttribute failed\n"); grid = -1; return; }
        if (hipOccupancyMaxActiveBlocksPerMultiprocessor(&per_cu, (const void*)fwd_kernel, NTHR, LDS_BYTES) != hipSuccess || per_cu < 1) { fprintf(stderr, "kernel_launch: occupancy query says %d\n", per_cu); }
        (void)hipGetLastError();
        grid = cus;
    }
    if (grid < 0) return;
    (void)hipMemsetAsync((char*)d_ws + WS_CTL, 0, CTL_ZERO_BYTES, stream);
    Args a{};
    for (int i = 0; i < 29; ++i) a.in[i] = (const float*)d_in[i];
    a.out = (float*)d_out; a.ws = (unsigned char*)d_ws;
#if MK_MULTI
    for (int p = 0; p < N_PHASES; ++p) { a.ph_lo = p; a.ph_hi = p + 1; hipLaunchKernelGGL(fwd_kernel, dim3(grid), dim3(NTHR), LDS_BYTES, stream, a); }
#else
    a.ph_lo = 0; a.ph_hi = N_PHASES;
    hipLaunchKernelGGL(fwd_kernel, dim3(grid), dim3(NTHR), LDS_BYTES, stream, a);
#endif
}
```
